# Optimizing an MI355X kernel written in HIP

```python
import math
import jax, jax.numpy as jnp
from jax import lax
import numpy as np

D_MODEL = 1024
BATCH = 32
SEQ = 2048
DEPTH = 2

MIX_WIDTH = D_MODEL
ATTN_HEADS = 8
HEAD_DIM = 64
ATTN_WIDTH = ATTN_HEADS * HEAD_DIM
DILATED_PATTERNS = ((128, 1), (512, 4), (2048, 16))
QUERY_BLOCK = 128
ROPE_THETA = 500000.0
ROPE_DIM = HEAD_DIM // 4
POOL_WINDOWS = (2, 4, 8, 16)
POOL_GROUPS = len(POOL_WINDOWS)
POOL_WIDTH = MIX_WIDTH - ATTN_WIDTH
POOL_GROUP_DIM = POOL_WIDTH // POOL_GROUPS
AB_IN_WIDTH = 3 * ATTN_WIDTH + POOL_WIDTH
SGU_CHUNK = 128
SGU_GROUPS = 8
SGU_WIDTH = MIX_WIDTH
SGU_GROUP_DIM = SGU_WIDTH // SGU_GROUPS
PEER_HEADS = 8
PEER_N_KEYS = 128
PEER_EXPERTS = PEER_N_KEYS * PEER_N_KEYS
PEER_TOPK = 16
PEER_QUERY_DIM = 256
PEER_HALF_DIM = PEER_QUERY_DIM // 2
PEER_TOKEN_BLOCK = 512
N_EVEN = (DEPTH + 1) // 2
N_ODD = DEPTH // 2
RMS_EPS = 1e-6
NEG_INF = -1e30

kernel_name = "hybrid_dilated_pool_sgu_peer_encoder"


def rms_norm(x, g):
    x32 = x.astype(jnp.float32)
    y = x32 * lax.rsqrt(jnp.mean(x32 * x32, axis=-1, keepdims=True) + RMS_EPS)
    return (y * g.astype(jnp.float32)).astype(x.dtype)


def partial_rotary(t):
    S = t.shape[1]
    half = ROPE_DIM // 2
    pos = jnp.arange(S, dtype=jnp.float32)
    inv_freq = ROPE_THETA ** (-jnp.arange(0, ROPE_DIM, 2, dtype=jnp.float32) / ROPE_DIM)
    ang = pos[:, None] * inv_freq[None, :]
    cos = jnp.cos(ang)[None, :, None, :]
    sin = jnp.sin(ang)[None, :, None, :]
    tr = t[..., :ROPE_DIM].astype(jnp.float32)
    t1, t2 = tr[..., :half], tr[..., half:]
    rot = jnp.concatenate([t1 * cos - t2 * sin, t2 * cos + t1 * sin], axis=-1)
    return jnp.concatenate([rot.astype(t.dtype), t[..., ROPE_DIM:]], axis=-1)


def banded_attention(q, k, v, half):
    N, L, H, dh = q.shape
    bq = math.gcd(L, QUERY_BLOCK)
    nb = L // bq
    kw = bq + 2 * half
    pad = ((0, 0), (half, half), (0, 0), (0, 0))
    kp = jnp.pad(k, pad)
    vp = jnp.pad(v, pad)
    kidx = (jnp.arange(nb) * bq)[:, None] + jnp.arange(kw)[None, :]
    kb = kp[:, kidx]
    vb = vp[:, kidx]
    qb = q.reshape(N, nb, bq, H, dh)
    s = jnp.einsum('nbqhd,nbkhd->nbhqk', qb, kb).astype(jnp.float32) * (dh ** -0.5)
    rel = jnp.arange(kw)[None, :] - half - jnp.arange(bq)[:, None]
    kpos = kidx - half
    valid = (jnp.abs(rel) <= half)[None] & ((kpos >= 0) & (kpos < L))[:, None, :]
    s = jnp.where(valid[None, :, None], s, NEG_INF)
    lse = jax.nn.logsumexp(s, axis=-1)
    p = jnp.exp(s - lse[..., None])
    o = jnp.einsum('nbhqk,nbkhd->nbqhd', p, vb.astype(jnp.float32))
    return o.reshape(N, L, H, dh), lse.transpose(0, 1, 3, 2).reshape(N, L, H)


def dilated_attention(q, k, v):
    B, S, H, dh = q.shape
    outs, lses = [], []
    for window, dil in DILATED_PATTERNS:
        half = window // (2 * dil)
        L = S // dil

        def strided(t):
            return t.reshape(B, L, dil, H, dh).transpose(0, 2, 1, 3, 4).reshape(B * dil, L, H, dh)

        o, lse = banded_attention(strided(q), strided(k), strided(v), half)
        outs.append(o.reshape(B, dil, L, H, dh).transpose(0, 2, 1, 3, 4).reshape(B, S, H, dh))
        lses.append(lse.reshape(B, dil, L, H).transpose(0, 2, 1, 3).reshape(B, S, H))
    w = jax.nn.softmax(jnp.stack(lses, axis=-1), axis=-1)
    out = jnp.einsum('bshdp,bshp->bshd', jnp.stack(outs, axis=-1), w)
    return out.reshape(B, S, H * dh).astype(q.dtype)


def multiscale_pool(u, w, scale):
    B, S, _ = u.shape
    ug = u.astype(jnp.float32).reshape(B, S, POOL_GROUPS, POOL_GROUP_DIM)
    c = jnp.pad(jnp.cumsum(ug, axis=1), ((0, 0), (1, 0), (0, 0), (0, 0)))
    pos = jnp.arange(S)
    pooled = []
    for g, win in enumerate(POOL_WINDOWS):
        lo = jnp.clip(pos - win // 2, 0, S)
        hi = jnp.clip(pos + win - win // 2, 0, S)
        cnt = (hi - lo).astype(jnp.float32)
        pooled.append((c[:, hi, g] - c[:, lo, g]) / cnt[None, :, None])
    pooled = jnp.stack(pooled, axis=2)
    mixed = jnp.einsum('bsgc,gcd->bsgd', pooled - ug, w.astype(jnp.float32))
    return (mixed.reshape(B, S, POOL_WIDTH) * scale.astype(jnp.float32)).astype(u.dtype)


def spatial_gating_mlp(h, w_in, norm_g, w_s, b_s, w_out):
    B, S, _ = h.shape
    z = jax.nn.gelu(h @ w_in)
    u, v = z[..., :SGU_WIDTH], z[..., SGU_WIDTH:]
    v = rms_norm(v, norm_g)
    nc = S // SGU_CHUNK
    vc = v.reshape(B, nc, SGU_CHUNK, SGU_GROUPS, SGU_GROUP_DIM)
    mixed = jnp.einsum('gpq,bnqgc->bnpgc', w_s, vc) + b_s.T[None, None, :, :, None]
    gated = u * mixed.reshape(B, S, SGU_WIDTH)
    return gated @ w_out


def peer(h, w_q, sub_keys, w_down, w_up):
    B, S, D = h.shape
    T = B * S
    ht = h.reshape(T, D)
    q = (ht @ w_q).reshape(T, PEER_HEADS, 2, PEER_HALF_DIM)
    scores = jnp.einsum('thic,hikc->thik', q, sub_keys).astype(jnp.float32)
    sv, si = lax.top_k(scores, PEER_TOPK)
    cand = sv[:, :, 0, :, None] + sv[:, :, 1, None, :]
    best, ci = lax.top_k(cand.reshape(T, PEER_HEADS, PEER_TOPK * PEER_TOPK), PEER_TOPK)
    i1 = jnp.take_along_axis(si[:, :, 0], ci // PEER_TOPK, axis=-1)
    i2 = jnp.take_along_axis(si[:, :, 1], ci % PEER_TOPK, axis=-1)
    expert = (i1 * PEER_N_KEYS + i2).reshape(T, PEER_HEADS * PEER_TOPK)
    gate = jax.nn.softmax(best, axis=-1).reshape(T, PEER_HEADS * PEER_TOPK)
    blk = math.gcd(T, PEER_TOKEN_BLOCK)
    nblk = T // blk

    def expert_block(args):
        xb, eb, gb = args
        hid = jax.nn.gelu(jnp.einsum('cd,ckd->ck', xb, w_down[eb]).astype(jnp.float32))
        return jnp.einsum('ck,ckd->cd', (gb * hid).astype(xb.dtype), w_up[eb])

    out = lax.map(expert_block, (ht.reshape(nblk, blk, D),
                                 expert.reshape(nblk, blk, PEER_HEADS * PEER_TOPK),
                                 gate.reshape(nblk, blk, PEER_HEADS * PEER_TOPK)))
    return out.reshape(B, S, D)


def setup_inputs(seed: int = 0) -> dict:
    key = jax.random.key(seed)
    ks = jax.random.split(key, 20)
    f32 = jnp.float32

    def nrm(k, shape, scale):
        return jax.random.normal(k, shape, f32) * scale

    return {
        "x": nrm(ks[0], (BATCH, SEQ, D_MODEL), 1.0),
        "norm_mix": 1.0 + nrm(ks[1], (DEPTH, D_MODEL), 0.02),
        "norm_ffn": 1.0 + nrm(ks[2], (DEPTH, D_MODEL), 0.02),
        "norm_final": 1.0 + nrm(ks[3], (D_MODEL,), 0.02),
        "ab_w_in": nrm(ks[4], (N_EVEN, D_MODEL, AB_IN_WIDTH), D_MODEL ** -0.5),
        "ab_w_out": nrm(ks[5], (N_EVEN, MIX_WIDTH, D_MODEL), MIX_WIDTH ** -0.5),
        "pool_w": nrm(ks[6], (N_EVEN, POOL_GROUPS, POOL_GROUP_DIM, POOL_GROUP_DIM), POOL_GROUP_DIM ** -0.5),
        "pool_scale": 1.0 + nrm(ks[7], (N_EVEN, POOL_WIDTH), 0.02),
        "c_w_in": nrm(ks[8], (N_ODD, D_MODEL, 2 * SGU_WIDTH), D_MODEL ** -0.5),
        "c_norm": 1.0 + nrm(ks[9], (N_ODD, SGU_WIDTH), 0.02),
        "c_w_s": nrm(ks[10], (N_ODD, SGU_GROUPS, SGU_CHUNK, SGU_CHUNK), SGU_CHUNK ** -0.5),
        "c_b_s": 1.0 + nrm(ks[11], (N_ODD, SGU_GROUPS, SGU_CHUNK), 0.02),
        "c_w_out": nrm(ks[12], (N_ODD, SGU_WIDTH, D_MODEL), SGU_WIDTH ** -0.5),
        "peer_w_q": nrm(ks[13], (DEPTH, D_MODEL, PEER_HEADS * PEER_QUERY_DIM), D_MODEL ** -0.5),
        "peer_sub_keys": nrm(ks[14], (DEPTH, PEER_HEADS, 2, PEER_N_KEYS, PEER_HALF_DIM), PEER_HALF_DIM ** -0.5),
        "peer_w_down": nrm(ks[15], (DEPTH, PEER_EXPERTS, D_MODEL), D_MODEL ** -0.5),
        "peer_w_up": nrm(ks[16], (DEPTH, PEER_EXPERTS, D_MODEL), PEER_HEADS ** -0.5),
    }


def reference(x, norm_mix, norm_ffn, norm_final, ab_w_in, ab_w_out, pool_w, pool_scale,
              c_w_in, c_norm, c_w_s, c_b_s, c_w_out,
              peer_w_q, peer_sub_keys, peer_w_down, peer_w_up):
    B, S, _ = x.shape
    for layer in range(DEPTH):
        j = layer // 2
        h = rms_norm(x, norm_mix[layer])
        if layer % 2 == 0:
            proj = h @ ab_w_in[j]
            q = proj[..., :ATTN_WIDTH].reshape(B, S, ATTN_HEADS, HEAD_DIM)
            k = proj[..., ATTN_WIDTH:2 * ATTN_WIDTH].reshape(B, S, ATTN_HEADS, HEAD_DIM)
            v = proj[..., 2 * ATTN_WIDTH:3 * ATTN_WIDTH].reshape(B, S, ATTN_HEADS, HEAD_DIM)
            p_in = proj[..., 3 * ATTN_WIDTH:]
            a_out = dilated_attention(partial_rotary(q), partial_rotary(k), v)
            b_out = multiscale_pool(p_in, pool_w[j], pool_scale[j])
            mix = jnp.concatenate([a_out, b_out], axis=-1) @ ab_w_out[j]
        else:
            mix = spatial_gating_mlp(h, c_w_in[j], c_norm[j], c_w_s[j], c_b_s[j], c_w_out[j])
        x = x + mix
        x = x + peer(rms_norm(x, norm_ffn[layer]), peer_w_q[layer], peer_sub_keys[layer],
                     peer_w_down[layer], peer_w_up[layer])
    return rms_norm(x, norm_final)
```

```cpp
#include <hip/hip_runtime.h>
#include <hip/hip_cooperative_groups.h>
#include <cstdio>
#include <cstdint>
namespace cg = cooperative_groups;


constexpr int BATCH = 32, SEQ = 2048, DM = 1024, T = BATCH * SEQ;
constexpr int NPROJ = 2048;
constexpr float RMS_EPS = 1e-6f;
constexpr float LOG2E = 1.4426950408889634f;
constexpr float QSCALE = 0.125f * LOG2E;
constexpr int NEXP = 16384;

constexpr size_t MiB = 1u << 20;
constexpr size_t WS_CTL = 0;
constexpr size_t WS_TAB = 1 * MiB;
constexpr size_t WS_SQ = 2 * MiB;
constexpr size_t WS_SQ2 = 6 * MiB;
constexpr size_t WS_WPOOL = 10 * MiB;
constexpr size_t WS_WS = 10 * MiB + 512 * 1024;
constexpr size_t WS_SK = 11 * MiB;
constexpr size_t WS_WABIN = 12 * MiB, WS_WABOUT = 16 * MiB, WS_WCIN = 18 * MiB, WS_WCOUT = 22 * MiB, WS_WQ0 = 24 * MiB, WS_WQ1 = 28 * MiB;
constexpr size_t WS_WDQ = 32 * MiB;
constexpr size_t WS_WUQ = 64 * MiB;
constexpr size_t WS_SDU = 96 * MiB;
constexpr size_t WS_XS = 97 * MiB;
constexpr size_t WS_XQ = 936 * MiB;
constexpr size_t WS_XA = 160 * MiB;
constexpr size_t WS_PROJ = 288 * MiB;
constexpr size_t WS_MIX = 544 * MiB;
constexpr size_t WS_EXP = 672 * MiB;
constexpr size_t WS_GATE = 704 * MiB;
constexpr size_t WS_OP = 736 * MiB;
constexpr size_t WS_LSE = 928 * MiB;
constexpr size_t WS_END = 1000 * MiB;

#define LAS __attribute__((address_space(3)))
typedef unsigned short bf16_t;
typedef short bf16x8 __attribute__((ext_vector_type(8)));
typedef short s16x4 __attribute__((ext_vector_type(4)));
typedef float f32x2 __attribute__((ext_vector_type(2)));
typedef float f32x4 __attribute__((ext_vector_type(4)));
typedef float f32x16 __attribute__((ext_vector_type(16)));
typedef unsigned u32x2 __attribute__((ext_vector_type(2)));
typedef unsigned u32x4 __attribute__((ext_vector_type(4)));
typedef __bf16 bf16x2_t __attribute__((ext_vector_type(2)));

__device__ __forceinline__ unsigned cvt_pk_bf16(float lo, float hi) { unsigned r; asm volatile("v_cvt_pk_bf16_f32 %0, %1, %2" : "=v"(r) : "v"(lo), "v"(hi)); return r; }
__device__ __forceinline__ float bf_lo(unsigned w) { return __uint_as_float(w << 16); }
__device__ __forceinline__ float bf_hi(unsigned w) { return __uint_as_float(w & 0xffff0000u); }
__device__ __forceinline__ float dot2_bf16(unsigned w, unsigned x, float acc) { return __builtin_amdgcn_fdot2_f32_bf16(__builtin_bit_cast(bf16x2_t, w), __builtin_bit_cast(bf16x2_t, x), acc, false); }
__device__ __forceinline__ float wave_sum(float v) {
#pragma unroll
    for (int o = 1; o < 64; o <<= 1) v += __shfl_xor(v, o);
    return v;
}
__device__ __forceinline__ float gelu_tanh(float x) {
    const float u = x * (0.7978845608028654f + 0.035677408136300125f * x * x);
    const float e = __builtin_amdgcn_exp2f(-2.0f * LOG2E * u);
    return x * __builtin_amdgcn_rcpf(1.0f + e);
}

namespace pg8 {
constexpr int BM = 256, BK = 64, HALF = 128, HTB = HALF * BK * 2, STAGE_BYTES = 8 * HTB, NXCD = 8, WGM = 8;
__host__ __device__ __forceinline__ int lds_byte(int r, int c) { const int st = (r >> 4) * 2 + (c >> 5), rr = r & 15, cc = c & 31, ob = rr * 64 + cc * 2; return st * 1024 + (ob ^ (((ob >> 9) & 1) << 5)); }
__host__ __device__ __forceinline__ void stage_rc(int b, int& R, int& C) { const int st = b / 1024, sb = b % 1024, swz = sb ^ (((sb >> 9) & 1) << 5); R = (st >> 1) * 16 + swz / 64; C = (st & 1) * 32 + (swz % 64) / 2; }
__host__ __device__ __forceinline__ int perm32(int rho) { const int n = rho >> 4, i = rho & 15; return 8 * (i >> 2) + 4 * n + (i & 3); }

struct Unit { int pm, pn; };
struct Gemm { const bf16_t* A; const bf16_t* Bt; int M, N, K; };

struct StaticOrder {
    int nM, nN, nwg, G, c;
    __host__ __device__ void init(int M, int N, int G_, int c_) { nM = M / BM; nN = N / BM; nwg = nM * nN; G = G_; c = c_; }
    __host__ __device__ bool next(int i, Unit& u) const {
        const long L = (long)i * G + c; if (L >= nwg) return false;
        int wgid = (int)L; { const int q = nwg / NXCD, r = nwg % NXCD, xcd = wgid % NXCD, off = wgid / NXCD; wgid = (xcd < r ? xcd * (q + 1) : r * (q + 1) + (xcd - r) * q) + off; }
        const int nig = WGM * nN, gid = wgid / nig, fm = gid * WGM, gsz = (nM - fm) < WGM ? (nM - fm) : WGM;
        u.pm = fm + ((wgid % nig) % gsz); u.pn = (wgid % nig) / gsz; return true;
    }
};

template <class Epi>
__device__ __forceinline__ void gemm_phase(LAS unsigned char* lds, const Gemm g, const StaticOrder& S, const Epi& E) {
    const int tid = threadIdx.x, wid = __builtin_amdgcn_readfirstlane(tid >> 6), lane = tid & 63, wr = wid >> 2, wc = wid & 3, fr = lane & 15, fq = lane >> 4;
    const int K = g.K, nt = K / BK;
    unsigned voffA[2], voffB[2];
#pragma unroll
    for (int i = 0; i < 2; ++i) { int R, C; stage_rc(tid * 16 + i * 8192, R, C); const int Rb = (R & ~31) + perm32(R & 31);
        voffA[i] = (unsigned)(R * K + C) * 2u; voffB[i] = (unsigned)(Rb * K + C) * 2u; }
    const size_t kstep = (size_t)(BK * 2);
    const size_t hstep = (size_t)HALF * K * 2;
    const size_t tstep = 2 * hstep;
    const unsigned ldsw = (unsigned)wid * 1024u;
    const int aoff = lds_byte(wr * 64 + fr, fq * 8), boff = lds_byte(wc * 32 + fr, fq * 8);
#define PG8_SA(b, h) (((b) * 2 + (h)) * HTB)
#define PG8_SB(b, h) ((4 + (b) * 2 + (h)) * HTB)
#define PG8_STAGE(bufoff, gbase, voff) do { _Pragma("unroll") for (int _i = 0; _i < 2; ++_i) \
        __builtin_amdgcn_global_load_lds((const unsigned*)((const char*)(gbase) + (voff)[_i]), (LAS unsigned*)(lds + (bufoff) + ldsw + _i * 8192), 16, 0, 0); } while (0)
#define PG8_LDA(dst, b, h) do { _Pragma("unroll") for (int m = 0; m < 4; ++m) _Pragma("unroll") for (int k = 0; k < 2; ++k) dst[m][k] = *(const LAS bf16x8*)(lds + PG8_SA(b, h) + aoff + m * 2048 + k * 1024); } while (0)
#define PG8_LDB(dst, b, h) do { _Pragma("unroll") for (int n = 0; n < 2; ++n) _Pragma("unroll") for (int k = 0; k < 2; ++k) dst[n][k] = *(const LAS bf16x8*)(lds + PG8_SB(b, h) + boff + n * 2048 + k * 1024); } while (0)
#define PG8_MMA(ai, bj, At, Bt) do { __builtin_amdgcn_s_setprio(1); _Pragma("unroll") for (int m = 0; m < 4; ++m) _Pragma("unroll") for (int n = 0; n < 2; ++n) _Pragma("unroll") for (int k = 0; k < 2; ++k) \
        acc[ai][bj][m][n] = __builtin_amdgcn_mfma_f32_16x16x32_bf16(Bt[n][k], At[m][k], acc[ai][bj][m][n], 0, 0, 0); __builtin_amdgcn_s_setprio(0); } while (0)
#define PG8_WAIT_V(n) asm volatile("s_waitcnt vmcnt(" #n ")" ::: "memory")
#define PG8_WAIT_L(n) asm volatile("s_waitcnt lgkmcnt(" #n ")" ::: "memory")
#define PG8_BAR __builtin_amdgcn_s_barrier()
#define PG8_SCHED __builtin_amdgcn_sched_barrier(0)
    Unit cur, nxt; int ui = 0;
    if (!S.next(0, cur)) return;
    f32x4 acc[2][2][4][2];
#pragma unroll
    for (int a = 0; a < 2; ++a)
#pragma unroll
        for (int b = 0; b < 2; ++b)
#pragma unroll
            for (int m = 0; m < 4; ++m)
#pragma unroll
                for (int n = 0; n < 2; ++n) acc[a][b][m][n] = (f32x4){0.f, 0.f, 0.f, 0.f};
    bf16x8 At[4][2], B0[2][2], B1[2][2];
    const char* cA = (const char*)g.A + (size_t)cur.pm * tstep; const char* cB = (const char*)g.Bt + (size_t)cur.pn * tstep;
    PG8_STAGE(PG8_SB(0, 0), cB, voffB); PG8_STAGE(PG8_SB(0, 1), cB + hstep, voffB); PG8_STAGE(PG8_SA(0, 0), cA, voffA); PG8_STAGE(PG8_SA(0, 1), cA + hstep, voffA);
    if (wr == 1) PG8_BAR;
    PG8_WAIT_V(2); PG8_BAR;
    PG8_STAGE(PG8_SB(1, 0), cB + kstep, voffB); PG8_STAGE(PG8_SA(1, 0), cA + kstep, voffA); PG8_STAGE(PG8_SB(1, 1), cB + hstep + kstep, voffB);
    PG8_WAIT_V(6); PG8_BAR;
    for (;;) {
        const bool has_next = S.next(ui + 1, nxt);
        const char* nA = has_next ? (const char*)g.A + (size_t)nxt.pm * tstep : cA; const char* nB = has_next ? (const char*)g.Bt + (size_t)nxt.pn * tstep : cB;
        for (int t = 0; t < nt; t += 2) {
            const bool last = (t == nt - 2);
            const char* a1 = cA + (size_t)(t + 1) * kstep;
            const char* a2 = last ? nA : cA + (size_t)(t + 2) * kstep; const char* b2 = last ? nB : cB + (size_t)(t + 2) * kstep;
            const char* a3 = a2 + kstep; const char* b3 = b2 + kstep;
            PG8_LDB(B0, 0, 0); PG8_LDB(B1, 0, 1); PG8_SCHED; PG8_LDA(At, 0, 0); PG8_STAGE(PG8_SA(1, 1), a1 + hstep, voffA);
            PG8_WAIT_V(8); PG8_WAIT_L(0); PG8_BAR; PG8_MMA(0, 0, At, B0); PG8_MMA(0, 1, At, B1); PG8_BAR; PG8_SCHED;
            PG8_LDA(At, 0, 1); PG8_STAGE(PG8_SB(0, 0), b2, voffB); PG8_STAGE(PG8_SB(0, 1), b2 + hstep, voffB); PG8_STAGE(PG8_SA(0, 0), a2, voffA);
            PG8_WAIT_V(8); PG8_WAIT_L(0); PG8_BAR; PG8_MMA(1, 0, At, B0); PG8_MMA(1, 1, At, B1); PG8_BAR; PG8_SCHED;
            PG8_LDB(B0, 1, 0); PG8_LDB(B1, 1, 1); PG8_SCHED; PG8_LDA(At, 1, 0); PG8_STAGE(PG8_SA(0, 1), a2 + hstep, voffA);
            PG8_WAIT_V(8); PG8_WAIT_L(0); PG8_BAR; PG8_MMA(0, 0, At, B0); PG8_MMA(0, 1, At, B1); PG8_BAR; PG8_SCHED;
            PG8_LDA(At, 1, 1); PG8_STAGE(PG8_SB(1, 0), b3, voffB); PG8_STAGE(PG8_SB(1, 1), b3 + hstep, voffB); PG8_STAGE(PG8_SA(1, 0), a3, voffA);
            PG8_WAIT_V(8); PG8_WAIT_L(0); PG8_BAR; PG8_MMA(1, 0, At, B0); PG8_MMA(1, 1, At, B1); PG8_BAR; PG8_SCHED;
        }
        if (wr == 0) PG8_BAR;
        E(acc, cur, wr, wc, fr, fq);
        if (!has_next) break;
#pragma unroll
        for (int a = 0; a < 2; ++a)
#pragma unroll
            for (int b = 0; b < 2; ++b)
#pragma unroll
                for (int m = 0; m < 4; ++m)
#pragma unroll
                    for (int n = 0; n < 2; ++n) acc[a][b][m][n] = (f32x4){0.f, 0.f, 0.f, 0.f};
        cur = nxt; cA = nA; cB = nB; ++ui;
        if (wr == 1) PG8_BAR;
    }
    PG8_WAIT_V(0);
    PG8_BAR;
#undef PG8_SA
#undef PG8_SB
#undef PG8_STAGE
#undef PG8_LDA
#undef PG8_LDB
#undef PG8_MMA
#undef PG8_WAIT_V
#undef PG8_WAIT_L
#undef PG8_BAR
#undef PG8_SCHED
}

struct EpiProj {
    bf16_t* O; const float* tab; const float* sq;
    __device__ __forceinline__ void operator()(const f32x4 (&acc)[2][2][4][2], const Unit& u, int wr, int wc, int fr, int fq) const {
        const int row0 = u.pm * BM + wr * 64 + fr, col0 = u.pn * BM + wc * 32 + 8 * fq;
        const bool rot = (u.pn < 4) && ((wc & 1) == 0);
        const float sc = (u.pn < 2) ? QSCALE : 1.f;
#pragma unroll
        for (int ai = 0; ai < 2; ++ai)
#pragma unroll
            for (int m = 0; m < 4; ++m) {
                const int row = row0 + ai * HALF + m * 16;
                bf16_t* rowp = O + (size_t)row * NPROJ + col0;
                float rstd;
                { const f32x4* sp = (const f32x4*)(sq + (size_t)row * 16);
                  const f32x4 a = sp[0], b = sp[1], c = sp[2], d = sp[3];
                  const float s = ((a[0] + a[1]) + (a[2] + a[3])) + ((b[0] + b[1]) + (b[2] + b[3])) + ((c[0] + c[1]) + (c[2] + c[3])) + ((d[0] + d[1]) + (d[2] + d[3]));
                  rstd = __builtin_amdgcn_rsqf(s * (1.0f / DM) + RMS_EPS); }
                f32x4 t0, t1, t2, t3;
                if (rot) { const f32x4* tp = (const f32x4*)(tab + (size_t)(row & (SEQ - 1)) * 16); t0 = tp[0]; t1 = tp[1]; t2 = tp[2]; t3 = tp[3]; }
#pragma unroll
                for (int bj = 0; bj < 2; ++bj) {
                    f32x4 v0 = acc[ai][bj][m][0] * rstd, v1 = acc[ai][bj][m][1] * rstd;
                    if (rot) {
                        f32x4 p0, p1;
#pragma unroll
                        for (int j = 0; j < 4; ++j) { p0[j] = __shfl_xor(v0[j], 16); p1[j] = __shfl_xor(v1[j], 16); }
                        const float sg = (fq == 0) ? -1.f : ((fq == 1) ? 1.f : 0.f);
                        const bool on = fq < 2;
                        const float c0 = on ? t0[0] : 1.f, s0 = sg * t0[1], c1 = on ? t0[2] : 1.f, s1 = sg * t0[3];
                        const float c2 = on ? t1[0] : 1.f, s2 = sg * t1[1], c3 = on ? t1[2] : 1.f, s3 = sg * t1[3];
                        const float c4 = on ? t2[0] : 1.f, s4 = sg * t2[1], c5 = on ? t2[2] : 1.f, s5 = sg * t2[3];
                        const float c6 = on ? t3[0] : 1.f, s6 = sg * t3[1], c7 = on ? t3[2] : 1.f, s7 = sg * t3[3];
                        v0[0] = v0[0] * c0 + p0[0] * s0; v0[1] = v0[1] * c1 + p0[1] * s1; v0[2] = v0[2] * c2 + p0[2] * s2; v0[3] = v0[3] * c3 + p0[3] * s3;
                        v1[0] = v1[0] * c4 + p1[0] * s4; v1[1] = v1[1] * c5 + p1[1] * s5; v1[2] = v1[2] * c6 + p1[2] * s6; v1[3] = v1[3] * c7 + p1[3] * s7;
                    }
                    v0 = v0 * sc; v1 = v1 * sc;
                    u32x4 w; w.x = cvt_pk_bf16(v0[0], v0[1]); w.y = cvt_pk_bf16(v0[2], v0[3]); w.z = cvt_pk_bf16(v1[0], v1[1]); w.w = cvt_pk_bf16(v1[2], v1[3]);
                    *(u32x4*)(rowp + bj * HALF) = w;
                }
            }
    }
};
struct EpiRes {
    const float* basef; const bf16_t* baseb; bf16_t* xb; float* sq;
    __device__ __forceinline__ void operator()(const f32x4 (&acc)[2][2][4][2], const Unit& u, int wr, int wc, int fr, int fq) const {
        const int row0 = u.pm * BM + wr * 64 + fr, col0 = u.pn * BM + wc * 32 + 8 * fq;
#pragma unroll
        for (int ai = 0; ai < 2; ++ai)
#pragma unroll
            for (int m = 0; m < 4; ++m) {
                const int row = row0 + ai * HALF + m * 16;
                const size_t off = (size_t)row * DM + col0;
                float ss = 0.f;
#pragma unroll
                for (int bj = 0; bj < 2; ++bj) {
                    f32x4 b0, b1;
                    if (basef) { b0 = *(const f32x4*)(basef + off + bj * HALF); b1 = *(const f32x4*)(basef + off + bj * HALF + 4); }
                    else { const u32x4 bb = *(const u32x4*)(baseb + off + bj * HALF);
                        b0 = (f32x4){bf_lo(bb.x), bf_hi(bb.x), bf_lo(bb.y), bf_hi(bb.y)}; b1 = (f32x4){bf_lo(bb.z), bf_hi(bb.z), bf_lo(bb.w), bf_hi(bb.w)}; }
                    const f32x4 o0 = b0 + acc[ai][bj][m][0], o1 = b1 + acc[ai][bj][m][1];
                    u32x4 w; w.x = cvt_pk_bf16(o0[0], o0[1]); w.y = cvt_pk_bf16(o0[2], o0[3]); w.z = cvt_pk_bf16(o1[0], o1[1]); w.w = cvt_pk_bf16(o1[2], o1[3]);
                    *(u32x4*)(xb + off + bj * HALF) = w;
                    ss += (o0[0] * o0[0] + o0[1] * o0[1]) + (o0[2] * o0[2] + o0[3] * o0[3]) + (o1[0] * o1[0] + o1[1] * o1[1]) + (o1[2] * o1[2] + o1[3] * o1[3]);
                }
                ss += __shfl_xor(ss, 16); ss += __shfl_xor(ss, 32);
                if (fq == 0) sq[(size_t)row * 16 + u.pn * 4 + wc] = ss;
            }
    }
};
struct EpiScaled {
    bf16_t* O; int ldc; const float* sq; bool plain; bool frag;
    __device__ __forceinline__ void operator()(const f32x4 (&acc)[2][2][4][2], const Unit& u, int wr, int wc, int fr, int fq) const {
        const int row0 = u.pm * BM + wr * 64 + fr, col0 = u.pn * BM + wc * 32 + 8 * fq;
#pragma unroll
        for (int ai = 0; ai < 2; ++ai)
#pragma unroll
            for (int m = 0; m < 4; ++m) {
                const int row = row0 + ai * HALF + m * 16;
                float rstd = 1.f;
                if (!plain) {
                const f32x4* sp = (const f32x4*)(sq + (size_t)row * 16);
                const f32x4 a = sp[0], b = sp[1], c = sp[2], d = sp[3];
                const float s = ((a[0] + a[1]) + (a[2] + a[3])) + ((b[0] + b[1]) + (b[2] + b[3])) + ((c[0] + c[1]) + (c[2] + c[3])) + ((d[0] + d[1]) + (d[2] + d[3]));
                rstd = __builtin_amdgcn_rsqf(s * (1.0f / DM) + RMS_EPS);
                }
                bf16_t* rowp = O + (size_t)row * ldc + col0;
#pragma unroll
                for (int bj = 0; bj < 2; ++bj) {
                    const f32x4 v0 = acc[ai][bj][m][0] * rstd, v1 = acc[ai][bj][m][1] * rstd;
                    u32x4 w; w.x = cvt_pk_bf16(v0[0], v0[1]); w.y = cvt_pk_bf16(v0[2], v0[3]); w.z = cvt_pk_bf16(v1[0], v1[1]); w.w = cvt_pk_bf16(v1[2], v1[3]);
                    if (frag) {
                        const int c = col0 + bj * HALF, h = c >> 8, half = (c >> 7) & 1, hh = (c >> 6) & 1, s = (c >> 3) & 7;
                        const size_t chunk = ((((size_t)(row >> 5) * 8 + h) * 2 + half) * 8 + s) * 64 + (row & 31) + 32 * hh;
                        *(u32x4*)(O + chunk * 8) = w;
                    } else *(u32x4*)(rowp + bj * HALF) = w;
                }
            }
    }
};
struct EpiGelu {
    bf16_t* U; bf16_t* VT; float* sq2;
    __device__ __forceinline__ void operator()(const f32x4 (&acc)[2][2][4][2], const Unit& u, int wr, int wc, int fr, int fq) const {
        const int row0 = u.pm * BM + wr * 64 + fr;
        if (u.pn < 4) {
            const int col0 = u.pn * BM + wc * 32 + 8 * fq;
#pragma unroll
            for (int ai = 0; ai < 2; ++ai)
#pragma unroll
                for (int m = 0; m < 4; ++m) {
                    const int row = row0 + ai * HALF + m * 16;
                    bf16_t* rowp = U + (size_t)row * DM + col0;
#pragma unroll
                    for (int bj = 0; bj < 2; ++bj) {
                        const f32x4 a0 = acc[ai][bj][m][0], a1 = acc[ai][bj][m][1];
                        u32x4 w; w.x = cvt_pk_bf16(gelu_tanh(a0[0]), gelu_tanh(a0[1])); w.y = cvt_pk_bf16(gelu_tanh(a0[2]), gelu_tanh(a0[3]));
                        w.z = cvt_pk_bf16(gelu_tanh(a1[0]), gelu_tanh(a1[1])); w.w = cvt_pk_bf16(gelu_tanh(a1[2]), gelu_tanh(a1[3]));
                        *(u32x4*)(rowp + bj * HALF) = w;
                    }
                }
        } else {
            const int col0 = (u.pn - 4) * BM + wc * 32 + 8 * fq;
#pragma unroll
            for (int ai = 0; ai < 2; ++ai)
#pragma unroll
                for (int m = 0; m < 4; ++m) {
                    const int row = row0 + ai * HALF + m * 16;
                    bf16_t* vp = VT + (size_t)(row >> 7) * (DM * 128) + (row & 127);
                    float ss = 0.f;
#pragma unroll
                    for (int bj = 0; bj < 2; ++bj) {
#pragma unroll
                        for (int n = 0; n < 2; ++n)
#pragma unroll
                            for (int j = 0; j < 4; ++j) {
                                const float g = gelu_tanh(acc[ai][bj][m][n][j]);
                                ss += g * g;
                                vp[(size_t)(col0 + bj * HALF + 4 * n + j) * 128] = (bf16_t)(cvt_pk_bf16(g, 0.f) & 0xffffu);
                            }
                    }
                    ss += __shfl_xor(ss, 16); ss += __shfl_xor(ss, 32);
                    if (fq == 0) sq2[(size_t)row * 16 + (u.pn - 4) * 4 + wc] = ss;
                }
        }
    }
};
}

constexpr int RING_BYTES = 131072;
constexpr int LDS_BYTES = 147456;
constexpr int LDS_BARST = LDS_BYTES - 64;
constexpr int NWAVES = 8;

struct Args { const float* in[17]; float* out; unsigned char* ws; int ph_lo, ph_hi; };

__device__ __forceinline__ void p0_transpose_item(const float* W, int K, int N, bf16_t* WT, const float* gk, const float* gn, LAS float* scr, int item, int lane) {
    const int nblk = N / 32, kb = item / nblk, nb = item % nblk, k0 = 64 * kb, n0 = 32 * nb;
#pragma unroll 8
    for (int i = 0; i < 32; ++i) { const int kk = 2 * i + (lane >> 5); float v = W[(size_t)(k0 + kk) * N + n0 + (lane & 31)];
        if (gk) v *= gk[k0 + kk]; if (gn) v *= gn[n0 + (lane & 31)]; scr[kk * 33 + (lane & 31)] = v; }
    asm volatile("s_waitcnt lgkmcnt(0)" ::: "memory");
    const int c = lane & 7;
#pragma unroll
    for (int j = 0; j < 4; ++j) { const int n = (lane >> 3) + 8 * j; const LAS float* s = scr + (8 * c) * 33 + n;
        u32x4 o; o.x = cvt_pk_bf16(s[0 * 33], s[1 * 33]); o.y = cvt_pk_bf16(s[2 * 33], s[3 * 33]); o.z = cvt_pk_bf16(s[4 * 33], s[5 * 33]); o.w = cvt_pk_bf16(s[6 * 33], s[7 * 33]);
        *(u32x4*)(WT + (size_t)(n0 + n) * K + k0 + 8 * c) = o; }
    asm volatile("s_waitcnt lgkmcnt(0)" ::: "memory");
}
__device__ __forceinline__ void p0_convert(const float* src, bf16_t* dst, size_t n, const float* gain, size_t gw, size_t ngw, int lane) {
    const size_t nvec = n / 8;
    for (size_t i = gw * 64 + lane; i < nvec; i += ngw * 64) {
        f32x4 a = *(const f32x4*)(src + i * 8), b = *(const f32x4*)(src + i * 8 + 4);
        if (gain) { const size_t c = (i * 8) & 1023; const f32x4 ga = *(const f32x4*)(gain + c), gb = *(const f32x4*)(gain + c + 4); a = a * ga; b = b * gb; }
        u32x4 w; w.x = cvt_pk_bf16(a[0], a[1]); w.y = cvt_pk_bf16(a[2], a[3]); w.z = cvt_pk_bf16(b[0], b[1]); w.w = cvt_pk_bf16(b[2], b[3]);
        *(u32x4*)(dst + i * 8) = w;
    }
}
__device__ __forceinline__ void rms_row_to_bf16(const float* xrow, bf16_t* orow, int lane) {
    const f32x4* xr = (const f32x4*)xrow + lane;
    f32x4 v[4]; float s = 0.f;
#pragma unroll
    for (int j = 0; j < 4; ++j) { v[j] = xr[64 * j]; s += (v[j][0] * v[j][0] + v[j][1] * v[j][1]) + (v[j][2] * v[j][2] + v[j][3] * v[j][3]); }
    const float rstd = __builtin_amdgcn_rsqf(wave_sum(s) * (1.0f / DM) + RMS_EPS);
    u32x2* o8 = (u32x2*)orow + lane;
#pragma unroll
    for (int j = 0; j < 4; ++j) { u32x2 w; w.x = cvt_pk_bf16(v[j][0] * rstd, v[j][1] * rstd); w.y = cvt_pk_bf16(v[j][2] * rstd, v[j][3] * rstd); o8[64 * j] = w; }
}

__device__ __forceinline__ void p0_prologue(const Args& A, LAS unsigned char* lds, int vcu, int G, int wave, int lane) {
    unsigned char* ws = A.ws;
    LAS float* scr = (LAS float*)(lds + wave * 16384);
    const int gw = vcu * NWAVES + wave, NGW = G * NWAVES;
    const float* norm_mix = A.in[1]; const float* norm_ffn = A.in[2];
    constexpr int I_2048 = (DM / 64) * (2048 / 32), I_1024 = (DM / 64) * (1024 / 32), I_POOL = (128 / 64) * (128 / 32);
    constexpr int NITEMS = 4 * I_2048 + 2 * I_1024 + 4 * I_POOL;
    for (int it = gw; it < NITEMS; it += NGW) {
        int r = it;
        if (r < I_2048) { p0_transpose_item(A.in[4], DM, 2048, (bf16_t*)(ws + WS_WABIN), norm_mix, nullptr, scr, r, lane); continue; } r -= I_2048;
        if (r < I_2048) { p0_transpose_item(A.in[8], DM, 2048, (bf16_t*)(ws + WS_WCIN), norm_mix + DM, nullptr, scr, r, lane); continue; } r -= I_2048;
        if (r < I_2048) { p0_transpose_item(A.in[13], DM, 2048, (bf16_t*)(ws + WS_WQ0), norm_ffn, nullptr, scr, r, lane); continue; } r -= I_2048;
        if (r < I_2048) { p0_transpose_item(A.in[13] + (size_t)DM * 2048, DM, 2048, (bf16_t*)(ws + WS_WQ1), norm_ffn + DM, nullptr, scr, r, lane); continue; } r -= I_2048;
        if (r < I_1024) { p0_transpose_item(A.in[5], DM, 1024, (bf16_t*)(ws + WS_WABOUT), nullptr, nullptr, scr, r, lane); continue; } r -= I_1024;
        if (r < I_1024) { p0_transpose_item(A.in[12], DM, 1024, (bf16_t*)(ws + WS_WCOUT), nullptr, nullptr, scr, r, lane); continue; } r -= I_1024;
        { const int g = r / I_POOL, ri = r % I_POOL;
          p0_transpose_item(A.in[6] + (size_t)g * 128 * 128, 128, 128, (bf16_t*)(ws + WS_WPOOL) + (size_t)g * 128 * 128, nullptr, A.in[7] + g * 128, scr, ri, lane); }
    }
    for (int ch = gw * 64 + lane; ch < 2 * 8 * 2 * 4 * 8 * 64; ch += NGW * 64) {
        const int ln = ch & 63, s = (ch >> 6) & 7, kb = (ch >> 9) & 3, hi = ch >> 11;
        const float* sp = A.in[14] + ((size_t)hi * 128 + kb * 32 + (ln & 31)) * 128 + 64 * (ln >> 5) + 8 * s;
        const f32x4 a = *(const f32x4*)sp, b = *(const f32x4*)(sp + 4);
        u32x4 w; w.x = cvt_pk_bf16(a[0], a[1]); w.y = cvt_pk_bf16(a[2], a[3]); w.z = cvt_pk_bf16(b[0], b[1]); w.w = cvt_pk_bf16(b[2], b[3]);
        *(u32x4*)((bf16_t*)(ws + WS_SK) + (size_t)ch * 8) = w;
    }
    p0_convert(A.in[10], (bf16_t*)(ws + WS_WS), (size_t)8 * 128 * 128, nullptr, gw, NGW, lane);
    for (int rix0 = gw; rix0 < 4 * NEXP; rix0 += 4 * NGW) {
        f32x4 v[4][4]; bool upv[4]; int rv[4]; bool okv[4];
#pragma unroll
        for (int u = 0; u < 4; ++u) {
            const int rix = rix0 + u * NGW; okv[u] = rix < 4 * NEXP;
            const int rc = okv[u] ? rix : rix0;
            upv[u] = rc >= 2 * NEXP; rv[u] = upv[u] ? rc - 2 * NEXP : rc;
            const f32x4* sp = (const f32x4*)((upv[u] ? A.in[16] : A.in[15]) + (size_t)rv[u] * DM + 16 * lane);
#pragma unroll
            for (int j = 0; j < 4; ++j) v[u][j] = sp[j];
        }
        float am[4];
#pragma unroll
        for (int u = 0; u < 4; ++u) {
            if (!upv[u]) { const f32x4* gp = (const f32x4*)(norm_ffn + (rv[u] / NEXP) * DM + 16 * lane);
#pragma unroll
                for (int j = 0; j < 4; ++j) v[u][j] = v[u][j] * gp[j]; }
            float m = 0.f;
#pragma unroll
            for (int j = 0; j < 4; ++j) m = fmaxf(m, fmaxf(fmaxf(fabsf(v[u][j][0]), fabsf(v[u][j][1])), fmaxf(fabsf(v[u][j][2]), fabsf(v[u][j][3]))));
            am[u] = m;
        }
#pragma unroll
        for (int o = 1; o < 64; o <<= 1)
#pragma unroll
            for (int u = 0; u < 4; ++u) am[u] = fmaxf(am[u], __shfl_xor(am[u], o));
#pragma unroll
        for (int u = 0; u < 4; ++u) {
            if (!okv[u]) continue;
            const float amx = fmaxf(am[u], 1e-20f); const int r = rv[u];
            if (!upv[u]) {
                const float inv = 127.0f / amx;
                u32x4 w;
#pragma unroll
                for (int j = 0; j < 4; ++j) {
                    const int q0 = (int)rintf(v[u][j][0] * inv), q1 = (int)rintf(v[u][j][1] * inv), q2 = (int)rintf(v[u][j][2] * inv), q3 = (int)rintf(v[u][j][3] * inv);
                    w[j] = (unsigned)(q0 & 0xff) | ((unsigned)(q1 & 0xff) << 8) | ((unsigned)(q2 & 0xff) << 16) | ((unsigned)q3 << 24);
                }
                *(u32x4*)(ws + WS_WDQ + (size_t)r * DM + 16 * lane) = w;
                if (lane == 0) ((float*)(ws + WS_SDU))[2 * r] = amx * (1.0f / 127.0f);
            } else {
                const float inv = 6.0f / amx;
                u32x2 w4;
#pragma unroll
                for (int q = 0; q < 2; ++q) {
                    unsigned p = 0u;
                    p = __builtin_amdgcn_cvt_scalef32_pk_fp4_f32(p, v[u][2 * q][0] * inv, v[u][2 * q][1] * inv, 1.0f, 0);
                    p = __builtin_amdgcn_cvt_scalef32_pk_fp4_f32(p, v[u][2 * q][2] * inv, v[u][2 * q][3] * inv, 1.0f, 1);
                    p = __builtin_amdgcn_cvt_scalef32_pk_fp4_f32(p, v[u][2 * q + 1][0] * inv, v[u][2 * q + 1][1] * inv, 1.0f, 2);
                    p = __builtin_amdgcn_cvt_scalef32_pk_fp4_f32(p, v[u][2 * q + 1][2] * inv, v[u][2 * q + 1][3] * inv, 1.0f, 3);
                    w4[q] = p;
                }
                *(u32x2*)(ws + WS_WUQ + (size_t)r * (DM / 2) + 8 * lane) = w4;
                if (lane == 0) ((float*)(ws + WS_SDU))[2 * r + 1] = amx * (1.0f / 6.0f);
            }
        }
    }
    { float* tab = (float*)(ws + WS_TAB);
      for (int e = gw * 64 + lane; e < SEQ * 8; e += NGW * 64) {
          const int pos = e >> 3, i = e & 7;
          const float inv_freq = __builtin_amdgcn_exp2f(-(float)i * (18.931568569324174f / 8.0f));
          const float ang = (float)pos * inv_freq;
          const float kq = rintf(ang * 0.6366197723675814f);
          float r = fmaf(-kq, 1.5707963705062866f, ang); r = fmaf(-kq, -4.371138828673793e-08f, r);
          const float sr = __sinf(r), cr = __cosf(r);
          const int q = ((int)kq) & 3;
          const float s = (q == 0) ? sr : (q == 1) ? cr : (q == 2) ? -sr : -cr;
          const float c = (q == 0) ? cr : (q == 1) ? -sr : (q == 2) ? -cr : sr;
          tab[2 * e] = c; tab[2 * e + 1] = s;
      } }
    for (int m0 = gw; m0 < T; m0 += 4 * NGW) {
        f32x4 v[4][4]; float s[4];
#pragma unroll
        for (int u = 0; u < 4; ++u) { const int m = (m0 + u * NGW < T) ? m0 + u * NGW : m0; const f32x4* xr = (const f32x4*)(A.in[0] + (size_t)m * DM) + lane;
#pragma unroll
            for (int j = 0; j < 4; ++j) v[u][j] = xr[64 * j]; }
#pragma unroll
        for (int u = 0; u < 4; ++u) { float q = 0.f;
#pragma unroll
            for (int j = 0; j < 4; ++j) q += (v[u][j][0] * v[u][j][0] + v[u][j][1] * v[u][j][1]) + (v[u][j][2] * v[u][j][2] + v[u][j][3] * v[u][j][3]);
            s[u] = q; }
#pragma unroll
        for (int o = 1; o < 64; o <<= 1)
#pragma unroll
            for (int u = 0; u < 4; ++u) s[u] += __shfl_xor(s[u], o);
#pragma unroll
        for (int u = 0; u < 4; ++u) {
            const int m = m0 + u * NGW; if (m >= T) continue;
            u32x2* o8 = (u32x2*)((bf16_t*)(ws + WS_XA) + (size_t)m * DM) + lane;
#pragma unroll
            for (int j = 0; j < 4; ++j) { u32x2 w; w.x = cvt_pk_bf16(v[u][j][0], v[u][j][1]); w.y = cvt_pk_bf16(v[u][j][2], v[u][j][3]); o8[64 * j] = w; }
            if (lane < 16) ((float*)(ws + WS_SQ))[(size_t)m * 16 + lane] = (lane == 0) ? s[u] : 0.f;
        }
    }
}

__device__ __forceinline__ int crow(int r, int hi) { return (r & 3) + 8 * (r >> 2) + 4 * hi; }
__device__ __forceinline__ void attn_phase(const Args& A, LAS unsigned char* lds, int vcu, int G, int wave, int lane) {
    const bf16_t* PROJ = (const bf16_t*)(A.ws + WS_PROJ);
    bf16_t* OP = (bf16_t*)(A.ws + WS_OP);
    float* LSE = (float*)(A.ws + WS_LSE);
    LAS unsigned char* vbuf = lds + wave * 17408;
    LAS unsigned char* kbuf = vbuf + 8192;
    const int r32 = lane & 31, hh = lane >> 5, i16 = lane & 15;
    for (int bh = vcu; bh < BATCH * 8; bh += G) {
        const int b = bh >> 3, h = bh & 7;
        const bf16_t* base = PROJ + (size_t)b * SEQ * NPROJ + h * 64;
        for (int ti = wave; ti < 96; ti += NWAVES) {
            const int pat = ti >> 5, sub = ti & 31;
            int dil, res, lq0;
            if (pat == 0) { dil = 1; res = 0; lq0 = sub * 64; } else if (pat == 1) { dil = 4; res = sub >> 3; lq0 = (sub & 7) * 64; } else { dil = 16; res = sub >> 1; lq0 = (sub & 1) * 64; }
            const int L = SEQ / dil;
            bf16x8 Qf[2][4];
#pragma unroll
            for (int u = 0; u < 2; ++u) { const bf16_t* qp = base + (size_t)((lq0 + 32 * u + r32) * dil + res) * NPROJ + 32 * hh;
#pragma unroll
              for (int s = 0; s < 4; ++s) Qf[u][s] = *(const bf16x8*)(qp + 8 * s); }
            float m_run[2] = {-1e30f, -1e30f}, lsum[2] = {0.f, 0.f};
            f32x16 OT[2][2];
#pragma unroll
            for (int u = 0; u < 2; ++u)
#pragma unroll
                for (int i = 0; i < 16; ++i) { OT[u][0][i] = 0.f; OT[u][1][i] = 0.f; }
            int vb = 0;
#define BLK_J(jj) (((jj) < 2) ? (jj) + 2 : ((jj) < 4 ? (jj) - 2 : (jj)))
#define BLK_OK(jj) (!((lq0 - 64 + 32 * BLK_J(jj)) + 32 <= 0 || (lq0 - 64 + 32 * BLK_J(jj)) >= L))
#define BLK_LOAD(jj) do { const int lkb_ = lq0 - 64 + 32 * BLK_J(jj); _Pragma("unroll") for (int i = 0; i < 4; ++i) { const int lk = lkb_ + i * 8 + (lane >> 3); \
                const bf16_t* rp = base + (size_t)(lk * dil + res) * NPROJ + (lane & 7) * 8; kkN[i] = *(const u32x4*)(rp + 512); vvN[i] = *(const u32x4*)(rp + 1024); } } while (0)
            u32x4 kkN[4], vvN[4];
            BLK_LOAD(0);
#pragma unroll 1
            for (int jj = 0; jj < 6; ++jj) {
                if (!BLK_OK(jj)) continue;
                const int jblk = BLK_J(jj);
                const int lk0 = lq0 - 64 + 32 * jblk;
                LAS unsigned char* vl = vbuf + vb * 4096; LAS unsigned char* kl = kbuf + vb * 4608; vb ^= 1;
#pragma unroll
                for (int i = 0; i < 4; ++i) { *(LAS u32x4*)(kl + (i * 8 + (lane >> 3)) * 144 + (lane & 7) * 16) = kkN[i];
                    *(LAS u32x4*)(vl + (i * 8 + (lane >> 3)) * 128 + (lane & 7) * 16) = vvN[i]; }
                { int nj = jj + 1; while (nj < 6 && !BLK_OK(nj)) ++nj; if (nj < 6) BLK_LOAD(nj); }
                bf16x8 Kf[4];
#pragma unroll
                for (int s = 0; s < 4; ++s) Kf[s] = *(const LAS bf16x8*)(kl + r32 * 144 + 64 * hh + 16 * s);
                bf16x8 Vf[2][2];
#pragma unroll
                for (int db = 0; db < 2; ++db)
#pragma unroll
                    for (int s = 0; s < 2; ++s) {
                        const int R0 = 16 * s + 4 * hh, C0 = 32 * db + 16 * ((lane >> 4) & 1);
                        LAS unsigned char* a0 = vl + (R0 + (i16 >> 2)) * 128 + (C0 + 4 * (i16 & 3)) * 2;
                        const s16x4 t0 = __builtin_bit_cast(s16x4, __builtin_amdgcn_ds_read_tr16_b64_v4i16((LAS s16x4*)a0));
                        const s16x4 t1 = __builtin_bit_cast(s16x4, __builtin_amdgcn_ds_read_tr16_b64_v4i16((LAS s16x4*)(a0 + 8 * 128)));
                        Vf[db][s] = (bf16x8){t0[0], t0[1], t0[2], t0[3], t1[0], t1[1], t1[2], t1[3]};
                    }
#pragma unroll
                for (int u = 0; u < 2; ++u) {
                    const int jrel = jblk - u;
                    if (jrel < 0 || jrel > 4) continue;
                    const int lq = lq0 + 32 * u + r32;
                    f32x16 st;
#pragma unroll
                    for (int i = 0; i < 16; ++i) st[i] = 0.f;
#pragma unroll
                    for (int s = 0; s < 4; ++s) st = __builtin_amdgcn_mfma_f32_32x32x16_bf16(Kf[s], Qf[u][s], st, 0, 0, 0);
                    if (jrel == 0 || jrel == 4) {
#pragma unroll
                        for (int r = 0; r < 16; ++r) {
                            const int d = lk0 + crow(r, hh) - lq;
                            st[r] = (d <= 64 && d >= -64) ? st[r] : -1e30f;
                        }
                    }
                    float mb = fmaxf(st[0], st[1]);
#pragma unroll
                    for (int r = 2; r < 16; ++r) mb = fmaxf(mb, st[r]);
                    mb = fmaxf(mb, __shfl_xor(mb, 32));
                    if (__builtin_amdgcn_ballot_w64(mb > m_run[u] + 6.0f) != 0ull) {
                        const float m_new = fmaxf(m_run[u], mb);
                        const float alpha = __builtin_amdgcn_exp2f(m_run[u] - m_new);
                        m_run[u] = m_new;
                        lsum[u] *= alpha;
#pragma unroll
                        for (int i = 0; i < 16; ++i) { OT[u][0][i] *= alpha; OT[u][1][i] *= alpha; }
                    }
                    float ps = 0.f;
#pragma unroll
                    for (int r = 0; r < 16; ++r) { st[r] = __builtin_amdgcn_exp2f(st[r] - m_run[u]); ps += st[r]; }
                    lsum[u] += ps;
#pragma unroll
                    for (int s = 0; s < 2; ++s) {
                        u32x4 w; w.x = cvt_pk_bf16(st[8 * s + 0], st[8 * s + 1]); w.y = cvt_pk_bf16(st[8 * s + 2], st[8 * s + 3]);
                        w.z = cvt_pk_bf16(st[8 * s + 4], st[8 * s + 5]); w.w = cvt_pk_bf16(st[8 * s + 6], st[8 * s + 7]);
                        const bf16x8 Pf = __builtin_bit_cast(bf16x8, w);
                        OT[u][0] = __builtin_amdgcn_mfma_f32_32x32x16_bf16(Vf[0][s], Pf, OT[u][0], 0, 0, 0);
                        OT[u][1] = __builtin_amdgcn_mfma_f32_32x32x16_bf16(Vf[1][s], Pf, OT[u][1], 0, 0, 0);
                    }
                }
                asm volatile("" ::: "memory");
            }
#undef BLK_J
#undef BLK_OK
#undef BLK_LOAD
#pragma unroll
            for (int u = 0; u < 2; ++u) {
                const float lt = lsum[u] + __shfl_xor(lsum[u], 32);
                const float inv = __builtin_amdgcn_rcpf(lt);
                const size_t row = (size_t)b * SEQ + (size_t)((lq0 + 32 * u + r32) * dil + res);
                bf16_t* op = OP + ((size_t)pat * T + row) * 512 + h * 64;
#pragma unroll
                for (int g4 = 0; g4 < 4; ++g4) {
                    u32x2 w0, w1;
                    w0.x = cvt_pk_bf16(OT[u][0][4 * g4 + 0] * inv, OT[u][0][4 * g4 + 1] * inv); w0.y = cvt_pk_bf16(OT[u][0][4 * g4 + 2] * inv, OT[u][0][4 * g4 + 3] * inv);
                    w1.x = cvt_pk_bf16(OT[u][1][4 * g4 + 0] * inv, OT[u][1][4 * g4 + 1] * inv); w1.y = cvt_pk_bf16(OT[u][1][4 * g4 + 2] * inv, OT[u][1][4 * g4 + 3] * inv);
                    *(u32x2*)(op + 8 * g4 + 4 * hh) = w0;
                    *(u32x2*)(op + 32 + 8 * g4 + 4 * hh) = w1;
                }
                if (hh == 0) LSE[((size_t)pat * T + row) * 8 + h] = m_run[u] + __builtin_amdgcn_logf(lt);
            }
        }
    }
}

template <int WIN>
__device__ __forceinline__ void pool_task(const bf16_t* PROJ, const bf16_t* WP, bf16_t* MIX, int g, int t0, int lane) {
    const int fr = lane & 15, fq = lane >> 4;
    constexpr int HW = WIN / 2;
    f32x4 acc[2][8];
#pragma unroll
    for (int m = 0; m < 2; ++m)
#pragma unroll
        for (int n = 0; n < 8; ++n) acc[m][n] = (f32x4){0.f, 0.f, 0.f, 0.f};
#pragma unroll 1
    for (int s = 0; s < 4; ++s) {
        bf16x8 Af[2];
        const bf16_t* colp = PROJ + 1536 + g * 128 + 32 * s + 8 * fq;
#pragma unroll
        for (int m = 0; m < 2; ++m) {
            const int t = t0 + m * 16 + fr, pos = t & (SEQ - 1);
            float sum[8];
#pragma unroll
            for (int k = 0; k < 8; ++k) sum[k] = 0.f;
            int cnt = 0;
            u32x4 self;
            constexpr int CH = WIN < 8 ? WIN : 8;
#pragma unroll
            for (int j0 = 0; j0 < WIN; j0 += CH) {
                u32x4 v[CH];
#pragma unroll
                for (int j = 0; j < CH; ++j) {
                    const int p = pos - HW + j0 + j;
                    const int pc = (p >= 0 && p < SEQ) ? p : pos;
                    v[j] = *(const u32x4*)(colp + (size_t)(t - pos + pc) * NPROJ);
                }
#pragma unroll
                for (int j = 0; j < CH; ++j) {
                    const int p = pos - HW + j0 + j;
                    const bool ok = (p >= 0) && (p < SEQ);
                    const float f = ok ? 1.f : 0.f; cnt += ok ? 1 : 0;
                    if (j0 + j == HW) self = v[j];
#pragma unroll
                    for (int k = 0; k < 4; ++k) { sum[2 * k] += f * bf_lo(v[j][k]); sum[2 * k + 1] += f * bf_hi(v[j][k]); }
                }
                if (WIN >= 16) asm volatile("" ::: "memory");
            }
            const float ic = 1.0f / (float)cnt;
            u32x4 w;
#pragma unroll
            for (int k = 0; k < 4; ++k) w[k] = cvt_pk_bf16(sum[2 * k] * ic - bf_lo(self[k]), sum[2 * k + 1] * ic - bf_hi(self[k]));
            Af[m] = __builtin_bit_cast(bf16x8, w);
        }
#pragma unroll
        for (int n = 0; n < 8; ++n) {
            const bf16x8 Wf = *(const bf16x8*)(WP + (size_t)g * 128 * 128 + (size_t)(n * 16 + fr) * 128 + 32 * s + 8 * fq);
#pragma unroll
            for (int m = 0; m < 2; ++m) acc[m][n] = __builtin_amdgcn_mfma_f32_16x16x32_bf16(Wf, Af[m], acc[m][n], 0, 0, 0);
        }
    }
#pragma unroll
    for (int m = 0; m < 2; ++m) {
        bf16_t* rowp = MIX + (size_t)(t0 + m * 16 + fr) * DM + 512 + g * 128 + 4 * fq;
#pragma unroll
        for (int n = 0; n < 8; ++n) { u32x2 w; w.x = cvt_pk_bf16(acc[m][n][0], acc[m][n][1]); w.y = cvt_pk_bf16(acc[m][n][2], acc[m][n][3]); *(u32x2*)(rowp + n * 16) = w; }
    }
}
__device__ __forceinline__ void mixab_phase(const Args& A, int vcu, int G, int wave, int lane) {
    const bf16_t* PROJ = (const bf16_t*)(A.ws + WS_PROJ);
    const bf16_t* OP = (const bf16_t*)(A.ws + WS_OP);
    const float* LSE = (const float*)(A.ws + WS_LSE);
    const bf16_t* WP = (const bf16_t*)(A.ws + WS_WPOOL);
    bf16_t* MIX = (bf16_t*)(A.ws + WS_MIX);
    const int gw = vcu * NWAVES + wave, NGW = G * NWAVES;
    for (int it0 = gw * 4; it0 < T; it0 += NGW * 4) {
        float l0[4], l1[4], l2[4]; u32x4 a[4], bq[4], c[4];
#pragma unroll
        for (int u = 0; u < 4; ++u) {
            const int th = (it0 + u) * 8 + (lane >> 3);
            const int t = th >> 3, h = th & 7, ch = lane & 7;
            l0[u] = LSE[((size_t)0 * T + t) * 8 + h]; l1[u] = LSE[((size_t)1 * T + t) * 8 + h]; l2[u] = LSE[((size_t)2 * T + t) * 8 + h];
            const size_t o = (size_t)t * 512 + h * 64 + ch * 8;
            a[u] = *(const u32x4*)(OP + o); bq[u] = *(const u32x4*)(OP + (size_t)T * 512 + o); c[u] = *(const u32x4*)(OP + (size_t)2 * T * 512 + o);
        }
#pragma unroll
        for (int u = 0; u < 4; ++u) {
            const int th = (it0 + u) * 8 + (lane >> 3);
            const int t = th >> 3, h = th & 7, ch = lane & 7;
            const float mx = fmaxf(l0[u], fmaxf(l1[u], l2[u]));
            float w0 = __builtin_amdgcn_exp2f(l0[u] - mx), w1 = __builtin_amdgcn_exp2f(l1[u] - mx), w2 = __builtin_amdgcn_exp2f(l2[u] - mx);
            const float inv = __builtin_amdgcn_rcpf(w0 + w1 + w2); w0 *= inv; w1 *= inv; w2 *= inv;
            u32x4 r;
#pragma unroll
            for (int k = 0; k < 4; ++k) {
                const float lo = w0 * bf_lo(a[u][k]) + w1 * bf_lo(bq[u][k]) + w2 * bf_lo(c[u][k]);
                const float hi = w0 * bf_hi(a[u][k]) + w1 * bf_hi(bq[u][k]) + w2 * bf_hi(c[u][k]);
                r[k] = cvt_pk_bf16(lo, hi);
            }
            *(u32x4*)(MIX + (size_t)t * DM + h * 64 + ch * 8) = r;
        }
    }
    for (int it = gw; it < (T / 32) * 4; it += NGW) {
        const int g = it & 3, t0 = (it >> 2) * 32;
        if (g == 0) pool_task<2>(PROJ, WP, MIX, 0, t0, lane);
        else if (g == 1) pool_task<4>(PROJ, WP, MIX, 1, t0, lane);
        else if (g == 2) pool_task<8>(PROJ, WP, MIX, 2, t0, lane);
        else pool_task<16>(PROJ, WP, MIX, 3, t0, lane);
    }
}

#define CE_DESC(x, a, b) do { const float _hi = fmaxf(x[a], x[b]); x[b] = fminf(x[a], x[b]); x[a] = _hi; } while (0)
#define CE_ASC(x, a, b)  do { const float _lo = fminf(x[a], x[b]); x[b] = fmaxf(x[a], x[b]); x[a] = _lo; } while (0)
__device__ __forceinline__ void bitonic_merge16_desc(float (&x)[16]) {
#pragma unroll
    for (int j = 8; j >= 1; j >>= 1)
#pragma unroll
        for (int i = 0; i < 16; ++i) { const int l = i ^ j; if (l > i) CE_DESC(x, i, l); }
}
__device__ __forceinline__ void bitonic_sort16_desc(float (&x)[16]) {
#pragma unroll
    for (int k = 2; k <= 16; k <<= 1)
#pragma unroll
        for (int j = k >> 1; j >= 1; j >>= 1)
#pragma unroll
            for (int i = 0; i < 16; ++i) { const int l = i ^ j; if (l > i) { if ((i & k) == 0) CE_DESC(x, i, l); else CE_ASC(x, i, l); } }
}
__device__ __forceinline__ void merge_top16(float (&L)[16], const float (&S)[16]) {
#pragma unroll
    for (int j = 0; j < 16; ++j) L[j] = fmaxf(L[j], S[15 - j]);
    bitonic_merge16_desc(L);
}
__device__ __forceinline__ void quant_rows(const struct Args& A, int row0, int lane);
#define INS16(L, v) do { float _v = (v); _Pragma("unroll") for (int _j = 0; _j < 16; ++_j) { const float _t = fmaxf(L[_j], _v); _v = fminf(L[_j], _v); L[_j] = _t; } } while (0)
__device__ __forceinline__ void topk_phase(const Args& A, LAS unsigned char* lds, int layer, int vcu, int G, int wave, int lane) {
    const bf16_t* Q2 = (const bf16_t*)(A.ws + WS_PROJ);
    const bf16_t* SK = (const bf16_t*)(A.ws + WS_SK) + (size_t)layer * 8 * 2 * 128 * 128;
    int* EXP = (int*)(A.ws + WS_EXP);
    float* GATE = (float*)(A.ws + WS_GATE);
    LAS unsigned* lidx = (LAS unsigned*)(lds + 65536 + wave * 8192);
    const int r32 = lane & 31, hh = lane >> 5, tid = threadIdx.x;
    for (int grp = vcu; grp < T / 256; grp += G) {
      const int tb = grp * 8 + wave;
#pragma unroll 1
      for (int i = 0; i < 8; ++i) quant_rows(A, tb * 32 + 4 * i, lane);
      bf16x8 QfN[8];
      { const bf16_t* qp = Q2 + ((((size_t)tb * 8 + 0) * 2 + 0) * 8 * 64 + lane) * 8;
#pragma unroll
        for (int s = 0; s < 8; ++s) QfN[s] = *(const bf16x8*)(qp + (size_t)s * 64 * 8); }
      u32x4 skn[8];
      { const u32x4* sp = (const u32x4*)SK + tid;
#pragma unroll
        for (int k = 0; k < 8; ++k) skn[k] = sp[k * 512]; }
#pragma unroll 1
      for (int h = 0; h < 8; ++h) {
        __syncthreads();
#pragma unroll
        for (int k = 0; k < 8; ++k) *(LAS u32x4*)(lds + (size_t)(tid + k * 512) * 16) = skn[k];
        if (h + 1 < 8) { const u32x4* sp = (const u32x4*)(SK + (size_t)(h + 1) * 2 * 128 * 128) + tid;
#pragma unroll
            for (int k = 0; k < 8; ++k) skn[k] = sp[k * 512]; }
        __syncthreads();
        const int t = tb * 32 + r32;
        float La[16], Lb[16];
#pragma unroll
        for (int half = 0; half < 2; ++half) {
            bf16x8 Qf[8];
            if (half == 0) {
#pragma unroll
                for (int s = 0; s < 8; ++s) Qf[s] = QfN[s];
                if (h + 1 < 8) { const bf16_t* qn = Q2 + ((((size_t)tb * 8 + h + 1) * 2 + 0) * 8 * 64 + lane) * 8;
#pragma unroll
                    for (int s = 0; s < 8; ++s) QfN[s] = *(const bf16x8*)(qn + (size_t)s * 64 * 8); }
            } else { const bf16_t* qp = Q2 + ((((size_t)tb * 8 + h) * 2 + half) * 8 * 64 + lane) * 8;
#pragma unroll
              for (int s = 0; s < 8; ++s) Qf[s] = *(const bf16x8*)(qp + (size_t)s * 64 * 8); }
            float Ls[16];
#pragma unroll
            for (int j = 0; j < 16; ++j) Ls[j] = -3.0e38f;
            const LAS unsigned char* skb = lds + (size_t)half * 32768 + lane * 16;
#pragma unroll 1
            for (int kb = 0; kb < 4; ++kb) {
                f32x16 st;
#pragma unroll
                for (int i = 0; i < 16; ++i) st[i] = 0.f;
                const LAS unsigned char* kp = skb + kb * 8192;
#pragma unroll
                for (int s = 0; s < 8; ++s) { const bf16x8 Kf = *(const LAS bf16x8*)(kp + s * 1024); st = __builtin_amdgcn_mfma_f32_32x32x16_bf16(Kf, Qf[s], st, 0, 0, 0); }
                float Sb[16];
#pragma unroll
                for (int r = 0; r < 16; ++r) {
                    const unsigned idx = (unsigned)(kb * 32 + crow(r, hh));
                    Sb[r] = __uint_as_float((__float_as_uint(st[r]) & 0xffffff80u) | idx);
                }
                bitonic_sort16_desc(Sb);
                merge_top16(Ls, Sb);
            }
            float Po[16];
#pragma unroll
            for (int j = 0; j < 16; ++j) Po[j] = __shfl_xor(Ls[j], 32);
            merge_top16(Ls, Po);
#pragma unroll
            for (int j = 0; j < 16; ++j) { if (half == 0) La[j] = Ls[j]; else Lb[j] = Ls[j]; }
        }
#pragma unroll
        for (int j = 0; j < 16; ++j) { lidx[j * 64 + lane] = __float_as_uint(La[j]) & 0x7fu; lidx[(16 + j) * 64 + lane] = __float_as_uint(Lb[j]) & 0x7fu; }
#define CAND(i, j) __uint_as_float((__float_as_uint(La[i] + Lb[j]) & 0xffffff00u) | (unsigned)((i) * 16 + (j)))
        float Lc[16], M1[16], Y[16];
#pragma unroll
        for (int j = 0; j < 16; ++j) Lc[j] = CAND(0, j);
#pragma unroll
        for (int j = 0; j < 8; ++j) { M1[j] = CAND(1, j); M1[15 - j] = CAND(8 + j, 0); }
        bitonic_merge16_desc(M1);
        Y[0] = CAND(2, 0); Y[1] = CAND(2, 1); Y[2] = CAND(2, 2); Y[3] = CAND(2, 3); Y[4] = CAND(2, 4);
        Y[5] = CAND(3, 0); Y[6] = CAND(3, 1); Y[7] = CAND(3, 2); Y[8] = CAND(3, 3);
        Y[9] = CAND(4, 0); Y[10] = CAND(4, 1); Y[11] = CAND(4, 2);
        Y[12] = CAND(5, 0); Y[13] = CAND(5, 1); Y[14] = CAND(6, 0); Y[15] = CAND(6, 1);
        bitonic_sort16_desc(Y);
        merge_top16(Lc, M1);
        merge_top16(Lc, Y);
        { const float c70 = CAND(7, 0), c71 = CAND(7, 1); INS16(Lc, c70); INS16(Lc, c71); }
#undef CAND
        float e[16]; float es = 0.f;
#pragma unroll
        for (int j = 0; j < 16; ++j) { e[j] = __builtin_amdgcn_exp2f((Lc[j] - Lc[0]) * LOG2E); es += e[j]; }
        const float inv = __builtin_amdgcn_rcpf(es);
        asm volatile("s_waitcnt lgkmcnt(0)" ::: "memory");
#pragma unroll
        for (int j = 0; j < 16; ++j) {
            const unsigned ci = __float_as_uint(Lc[j]) & 0xffu;
            const unsigned i1 = lidx[(ci >> 4) * 64 + lane], i2 = lidx[(16 + (ci & 15)) * 64 + lane];
            if ((j >> 3) == hh) {
                EXP[(size_t)t * 128 + h * 16 + j] = (int)(i1 * 128 + i2);
                GATE[(size_t)t * 128 + h * 16 + j] = e[j] * inv;
            }
        }
        asm volatile("s_waitcnt lgkmcnt(0)" ::: "memory");
      }
    }
}

#define XB_TMO      128
#define XB_XCNT(j)  (256  + 64 * (j))
#define XB_XSUB(j)  (1280 + 64 * (j))
#define XB_XGEN(j)  (2304 + 64 * (j))
#define XB_TOP      3328
#define XB_TOPGEN   3392
#define XCD_BAR_WORDS 3456
#define XB_SPIN_CAP (1u << 20)
__device__ __forceinline__ unsigned xb_ld(unsigned* p)              { return __hip_atomic_load(p, __ATOMIC_RELAXED, __HIP_MEMORY_SCOPE_AGENT); }
__device__ __forceinline__ unsigned xb_add(unsigned* p, unsigned v) { return __hip_atomic_fetch_add(p, v, __ATOMIC_RELAXED, __HIP_MEMORY_SCOPE_AGENT); }
__device__ __forceinline__ unsigned xb_xcc_id() { return (unsigned)__builtin_amdgcn_s_getreg((3 << 11) | 20) & 0xFu; }
#define XB_SPIN(cond, bar) do { unsigned _sp = 0; while (cond) { __builtin_amdgcn_s_sleep(1); \
    if ((++_sp & 255u) == 0u) { if (xb_ld(&(bar)[XB_TMO])) break; if (_sp > XB_SPIN_CAP) { atomicAdd(&(bar)[XB_TMO], 1u); break; } } } } while (0)
struct XcdBarrier { unsigned* bar; unsigned x; volatile LAS unsigned* st; };
__device__ __forceinline__ XcdBarrier xcd_barrier_post(unsigned* bar, volatile LAS unsigned* st) {
    XcdBarrier b; b.bar = bar; b.x = xb_xcc_id(); b.st = st;
    if (threadIdx.x == 0) (void)xb_add(&bar[XB_XCNT(b.x)], 1u);
    return b;
}
__device__ __forceinline__ void xcd_barrier_complete(unsigned* bar, unsigned x, unsigned& nloc, unsigned& nx) {
    const unsigned G = gridDim.x * gridDim.y * gridDim.z;
    unsigned sum, cnt, mine, sp = 0u;
    for (;;) {
        sum = 0u; cnt = 0u; mine = 0u;
#pragma unroll
        for (unsigned j = 0; j < 16; ++j) { const unsigned c = xb_ld(&bar[XB_XCNT(j)]); sum += c; cnt += (c > 0u) ? 1u : 0u; mine = (j == x) ? c : mine; }
        if (sum == G) break;
        __builtin_amdgcn_s_sleep(1);
        if ((++sp & 255u) == 0u) { if (xb_ld(&bar[XB_TMO])) break; if (sp > XB_SPIN_CAP) { atomicAdd(&bar[XB_TMO], 1u); break; } }
    }
    nloc = mine > 0u ? mine : 1u; nx = cnt > 0u ? cnt : 1u;
}
__device__ __forceinline__ void xcd_barrier(const XcdBarrier& b) {
    asm volatile("s_waitcnt vmcnt(0)" ::: "memory");
    __syncthreads();
    if (threadIdx.x == 0) {
        unsigned* bar = b.bar;
        __builtin_amdgcn_s_waitcnt(0);
        unsigned nloc = b.st[0], nx = b.st[1];
        if (nloc == 0u) { xcd_barrier_complete(bar, b.x, nloc, nx); b.st[0] = nloc; b.st[1] = nx; }
        const unsigned old = xb_add(&bar[XB_XSUB(b.x)], 1u);
        const unsigned gen = old / nloc;
        if (old + 1u == (gen + 1u) * nloc) {
            __builtin_amdgcn_fence(__ATOMIC_RELEASE, "agent");
            asm volatile("s_waitcnt vmcnt(0)" ::: "memory");
            const unsigned og = xb_add(&bar[XB_TOP], 1u);
            const unsigned tg = og / nx;
            if (og + 1u == (tg + 1u) * nx) xb_add(&bar[XB_TOPGEN], 1u);
            else XB_SPIN(xb_ld(&bar[XB_TOPGEN]) == tg, bar);
            __builtin_amdgcn_fence(__ATOMIC_ACQUIRE, "agent");
            xb_add(&bar[XB_XGEN(b.x)], 1u);
            asm volatile("s_waitcnt vmcnt(0)" ::: "memory");
        } else {
            XB_SPIN(xb_ld(&bar[XB_XGEN(b.x)]) == gen, bar);
            __builtin_amdgcn_fence(__ATOMIC_ACQUIRE, "agent");
            asm volatile("s_waitcnt vmcnt(0)" ::: "memory");
        }
    }
    __syncthreads();
}


__device__ __forceinline__ int dpp_sum_i32(int v) {
    v += __builtin_amdgcn_update_dpp(0, v, 0x111, 0xf, 0xf, true);
    v += __builtin_amdgcn_update_dpp(0, v, 0x112, 0xf, 0xf, true);
    v += __builtin_amdgcn_update_dpp(0, v, 0x114, 0xf, 0xf, true);
    v += __builtin_amdgcn_update_dpp(0, v, 0x118, 0xf, 0xf, true);
    v += __builtin_amdgcn_update_dpp(0, v, 0x142, 0xa, 0xf, false);
    v += __builtin_amdgcn_update_dpp(0, v, 0x143, 0xc, 0xf, false);
    return v;
}
__device__ __forceinline__ void quant_rows(const Args& A, int row0, int lane) {
    const bf16_t* XB = (const bf16_t*)(A.ws + WS_XA);
    const float* SQ = (const float*)(A.ws + WS_SQ);
    u32x4 a[4], b[4]; f32x4 s[4][4];
#pragma unroll
    for (int i = 0; i < 4; ++i) {
        const int t = row0 + i;
        a[i] = *(const u32x4*)(XB + (size_t)t * DM + 16 * lane); b[i] = *(const u32x4*)(XB + (size_t)t * DM + 16 * lane + 8);
        const f32x4* sp = (const f32x4*)(SQ + (size_t)t * 16);
        s[i][0] = sp[0]; s[i][1] = sp[1]; s[i][2] = sp[2]; s[i][3] = sp[3];
    }
    float am[4]; float h[4][16];
#pragma unroll
    for (int i = 0; i < 4; ++i) {
        const float ssum = ((s[i][0][0] + s[i][0][1]) + (s[i][0][2] + s[i][0][3])) + ((s[i][1][0] + s[i][1][1]) + (s[i][1][2] + s[i][1][3]))
                         + ((s[i][2][0] + s[i][2][1]) + (s[i][2][2] + s[i][2][3])) + ((s[i][3][0] + s[i][3][1]) + (s[i][3][2] + s[i][3][3]));
        const float rstd = __builtin_amdgcn_rsqf(ssum * (1.0f / DM) + RMS_EPS);
        float m = 0.f;
#pragma unroll
        for (int k = 0; k < 4; ++k) { h[i][2 * k] = bf_lo(a[i][k]) * rstd; h[i][2 * k + 1] = bf_hi(a[i][k]) * rstd; h[i][8 + 2 * k] = bf_lo(b[i][k]) * rstd; h[i][8 + 2 * k + 1] = bf_hi(b[i][k]) * rstd; }
#pragma unroll
        for (int k = 0; k < 16; ++k) m = fmaxf(m, fabsf(h[i][k]));
        am[i] = m;
    }
#pragma unroll
    for (int o = 1; o < 64; o <<= 1)
#pragma unroll
        for (int i = 0; i < 4; ++i) am[i] = fmaxf(am[i], __shfl_xor(am[i], o));
#pragma unroll
    for (int i = 0; i < 4; ++i) {
        const int t = row0 + i;
        const float amx = fmaxf(am[i], 1e-20f);
        const float inv = 127.0f / amx;
        u32x4 w;
#pragma unroll
        for (int j = 0; j < 4; ++j) {
            const int q0 = (int)rintf(h[i][4 * j] * inv), q1 = (int)rintf(h[i][4 * j + 1] * inv), q2 = (int)rintf(h[i][4 * j + 2] * inv), q3 = (int)rintf(h[i][4 * j + 3] * inv);
            w[j] = (unsigned)(q0 & 0xff) | ((unsigned)(q1 & 0xff) << 8) | ((unsigned)(q2 & 0xff) << 16) | ((unsigned)q3 << 24);
        }
        *(u32x4*)(A.ws + WS_XQ + (size_t)t * DM + 16 * lane) = w;
        if (lane == 0) ((float*)(A.ws + WS_XS))[t] = amx * (1.0f / 127.0f);
    }
}

constexpr int DOWN_TB = 512;
constexpr int DSTEP = 4;
typedef int i32x4 __attribute__((ext_vector_type(4)));
__device__ __forceinline__ int row_scan_add(int v) {
    v += __builtin_amdgcn_update_dpp(0, v, 0x111, 0xf, 0xf, true);
    v += __builtin_amdgcn_update_dpp(0, v, 0x112, 0xf, 0xf, true);
    v += __builtin_amdgcn_update_dpp(0, v, 0x114, 0xf, 0xf, true);
    v += __builtin_amdgcn_update_dpp(0, v, 0x118, 0xf, 0xf, true);
    return v;
}
__device__ __forceinline__ void expert_down_phase(const Args& A, LAS unsigned char* lds, int layer, int G, int bx, int wave, int lane, int mode = 0) {
    const unsigned char* WDQ = A.ws + WS_WDQ + (size_t)layer * NEXP * DM;
    const f32x2* SDU = (const f32x2*)(A.ws + WS_SDU) + layer * NEXP;
    const float* XS = (const float*)(A.ws + WS_XS);
    const int* EXP = (const int*)(A.ws + WS_EXP);
    const float* GATE = (const float*)(A.ws + WS_GATE);
    float* GOUT = mode ? (float*)(A.ws + WS_OP) : (float*)(A.ws + WS_GATE);
    const int emask = (mode == 2) ? 0x3f : 0x3fff;
    const int g = lane >> 4, i = lane & 15;
    LAS int* llist = (LAS int*)(lds + 16384 + wave * 6144) + g * 128;
    LAS float* lgate = (LAS float*)(llist + 512);
    LAS int* lres = llist + 1024;
    volatile LAS int* lq = (volatile LAS int*)(lds + 8192);
    unsigned* qh = (unsigned*)(A.ws + WS_CTL) + 8192 + (layer + (mode ? 2 : 0)) * 8 * 64;
    const int myx = (int)(xb_xcc_id() & 7u);
    constexpr int NITEM = T / DOWN_TB;
    for (int rr = 0; rr < 8; ++rr) {
        const int range = (myx + rr) & 7;
        for (;;) {
            __syncthreads();
            if (threadIdx.x == 0) lq[0] = (int)__hip_atomic_fetch_add(qh + range * 64, 1u, __ATOMIC_RELAXED, __HIP_MEMORY_SCOPE_AGENT);
            __syncthreads();
            const int item = lq[0];
            if (item >= NITEM) break;
            struct Hdr { u32x4 xq[4]; i32x4 ea, eb; f32x4 ga, gb; float st; };
#define HDR_LOAD(H, tt) do { _Pragma("unroll") for (int c = 0; c < 4; ++c) H.xq[c] = *(const u32x4*)(A.ws + WS_XQ + (size_t)(tt) * DM + 16 * i + 256 * c); \
                H.ea = *(const i32x4*)(EXP + (size_t)(tt) * 128 + 8 * i); H.eb = *(const i32x4*)(EXP + (size_t)(tt) * 128 + 8 * i + 4); \
                H.ga = *(const f32x4*)(GATE + (size_t)(tt) * 128 + 8 * i); H.gb = *(const f32x4*)(GATE + (size_t)(tt) * 128 + 8 * i + 4); H.st = XS[tt]; } while (0)
            const int tw = item * DOWN_TB + wave * (DOWN_TB / NWAVES) + g;
            constexpr int NIT = DOWN_TB / (NWAVES * 4);
            Hdr hn; HDR_LOAD(hn, tw);
#pragma unroll 1
            for (int it = 0; it < NIT; ++it) {
                const int t = tw + it * 4;
                const Hdr h = hn;
                int cnt = 0;
#pragma unroll
                for (int k = 0; k < 4; ++k) { cnt += ((h.ea[k] >> 11) == range) ? 1 : 0; cnt += ((h.eb[k] >> 11) == range) ? 1 : 0; }
                const int incl = row_scan_add(cnt);
                int pos = incl - cnt;
                const int n0 = __builtin_amdgcn_readlane(incl, 15), n1 = __builtin_amdgcn_readlane(incl, 31), n2 = __builtin_amdgcn_readlane(incl, 47), n3 = __builtin_amdgcn_readlane(incl, 63);
                const int ng = (g == 0) ? n0 : (g == 1) ? n1 : (g == 2) ? n2 : n3;
                int nmax = n0 > n1 ? n0 : n1; nmax = nmax > n2 ? nmax : n2; nmax = nmax > n3 ? nmax : n3;
#pragma unroll
                for (int k = 0; k < 8; ++k) {
                    const int e = (k < 4) ? h.ea[k & 3] : h.eb[k & 3]; const float gt = (k < 4) ? h.ga[k & 3] : h.gb[k & 3];
                    if ((e >> 11) == range) { llist[pos] = ((e & emask) << 8) | (8 * i + k); lgate[pos] = gt; ++pos; }
                }
                f32x2 sc0 = {0.f, 0.f}, sc1 = {0.f, 0.f};
                if (i < ng) sc0 = SDU[llist[i] >> 8];
                if (i + 16 < ng) sc1 = SDU[llist[i + 16] >> 8];
                bool pref = (it + 1 >= NIT) || mode == 6;
#pragma unroll 1
                for (int s0 = 0; s0 < nmax; s0 += DSTEP) {
                    u32x4 w[DSTEP][4];
#pragma unroll
                    for (int u = 0; u < DSTEP; ++u) {
                        if (s0 + u < ng) {
                            const unsigned char* rp = WDQ + (size_t)(llist[s0 + u] >> 8) * DM + 16 * i;
#pragma unroll
                            for (int c = 0; c < 4; ++c) w[u][c] = *(const u32x4*)(rp + 256 * c);
                        }
                    }
                    if (!pref) { pref = true; HDR_LOAD(hn, t + 4); }
                    int p[DSTEP];
#pragma unroll
                    for (int u = 0; u < DSTEP; ++u) {
                        int a0 = 0, a1 = 0, a2 = 0, a3 = 0;
#pragma unroll
                        for (int d = 0; d < 4; ++d) {
                            a0 = __builtin_amdgcn_sdot4((int)w[u][0][d], (int)h.xq[0][d], a0, false); a1 = __builtin_amdgcn_sdot4((int)w[u][1][d], (int)h.xq[1][d], a1, false);
                            a2 = __builtin_amdgcn_sdot4((int)w[u][2][d], (int)h.xq[2][d], a2, false); a3 = __builtin_amdgcn_sdot4((int)w[u][3][d], (int)h.xq[3][d], a3, false);
                        }
                        p[u] = (a0 + a1) + (a2 + a3);
                    }
#pragma unroll
                    for (int u = 0; u < DSTEP; ++u) p[u] += __builtin_amdgcn_update_dpp(0, p[u], 0x111, 0xf, 0xf, true);
#pragma unroll
                    for (int u = 0; u < DSTEP; ++u) p[u] += __builtin_amdgcn_update_dpp(0, p[u], 0x112, 0xf, 0xf, true);
#pragma unroll
                    for (int u = 0; u < DSTEP; ++u) p[u] += __builtin_amdgcn_update_dpp(0, p[u], 0x114, 0xf, 0xf, true);
#pragma unroll
                    for (int u = 0; u < DSTEP; ++u) p[u] += __builtin_amdgcn_update_dpp(0, p[u], 0x118, 0xf, 0xf, true);
#pragma unroll
                    for (int u = 0; u < DSTEP; ++u) if (i == 15 && s0 + u < ng) lres[s0 + u] = p[u];
                }
                if (!pref) HDR_LOAD(hn, t + 4);
                if (i < ng) { const int ent = llist[i]; GOUT[(size_t)t * 128 + (ent & 0xff)] = lgate[i] * gelu_tanh((float)lres[i] * h.st * sc0[0]) * sc0[1]; }
                if (i + 16 < ng) { const int ent = llist[i + 16]; GOUT[(size_t)t * 128 + (ent & 0xff)] = lgate[i + 16] * gelu_tanh((float)lres[i + 16] * h.st * sc1[0]) * sc1[1]; }
#pragma unroll 1
                for (int k = i + 32; k < nmax; k += 16) {
                    if (k < ng) {
                        const int ent = llist[k]; const f32x2 sc = SDU[ent >> 8];
                        GOUT[(size_t)t * 128 + (ent & 0xff)] = lgate[k] * gelu_tanh((float)lres[k] * h.st * sc[0]) * sc[1];
                    }
                }
            }
#undef HDR_LOAD
        }
    }
}

constexpr int UP_NT = 4;
__device__ __forceinline__ void expert_up_phase(const Args& A, LAS unsigned char* lds, int layer, int vcu, int G, int wave, int lane, bool dry = false, unsigned nloc = 0u) {
    const unsigned char* WUQ = A.ws + WS_WUQ + (size_t)layer * NEXP * (DM / 2);
    const int* EXP = (const int*)(A.ws + WS_EXP);
    const float* COEF = (const float*)(A.ws + WS_GATE);
    const bf16_t* X = (const bf16_t*)(A.ws + WS_XA);
    bf16_t* XO = (bf16_t*)(A.ws + (dry ? WS_PROJ : WS_XA));
    bf16_t* XN = (bf16_t*)(A.ws + (dry ? WS_PROJ + 128 * MiB : WS_OP));
    float* FO = dry ? (float*)(A.ws + WS_PROJ) : A.out;
    const float* gfin = A.in[3];
    const int gw = vcu * NWAVES + wave, NGW = G * NWAVES;
    int swi = 0;
    for (int t0 = gw * UP_NT; t0 < T; t0 += NGW * UP_NT, ++swi) {
        int e_lo[UP_NT], e_hi[UP_NT]; float c_lo[UP_NT], c_hi[UP_NT];
#pragma unroll
        for (int b = 0; b < UP_NT; ++b) { const size_t o = (size_t)(t0 + b) * 128; e_lo[b] = EXP[o + lane]; e_hi[b] = EXP[o + 64 + lane]; c_lo[b] = COEF[o + lane]; c_hi[b] = COEF[o + 64 + lane]; }
#pragma unroll
        for (int b = 0; b < UP_NT; ++b) {
            LAS int* se = (LAS int*)(lds + 16384 + wave * 1024); LAS float* sc = (LAS float*)(se + 128);
            const int r_lo = e_lo[b] >> 10, r_hi = e_hi[b] >> 10;
            int pos_lo = 0, pos_hi = 0, base = 0;
#pragma unroll
            for (int r = 0; r < 16; ++r) {
                const unsigned long long b0 = __builtin_amdgcn_ballot_w64(r_lo == r), b1 = __builtin_amdgcn_ballot_w64(r_hi == r);
                const int n0 = __builtin_popcountll(b0), n1 = __builtin_popcountll(b1);
                const int k0 = (int)__builtin_amdgcn_mbcnt_hi((unsigned)(b0 >> 32), __builtin_amdgcn_mbcnt_lo((unsigned)b0, 0u));
                const int k1 = (int)__builtin_amdgcn_mbcnt_hi((unsigned)(b1 >> 32), __builtin_amdgcn_mbcnt_lo((unsigned)b1, 0u));
                pos_lo = (r_lo == r) ? base + k0 : pos_lo; pos_hi = (r_hi == r) ? base + n0 + k1 : pos_hi;
                base += n0 + n1;
            }
            se[pos_lo] = e_lo[b]; sc[pos_lo] = c_lo[b]; se[pos_hi] = e_hi[b]; sc[pos_hi] = c_hi[b];
            e_lo[b] = se[lane]; e_hi[b] = se[64 + lane]; c_lo[b] = sc[lane]; c_hi[b] = sc[64 + lane];
        }
        __syncthreads();
        if (nloc) {
            if (threadIdx.x == 0) {
                unsigned* pc = (unsigned*)(A.ws + WS_CTL) + 12288 + ((dry ? 2 : 0) + layer) * 16 * 64 + (xb_xcc_id() & 15u) * 64;
                const unsigned want = nloc * (unsigned)(swi + 1);
                __hip_atomic_fetch_add(pc, 1u, __ATOMIC_RELAXED, __HIP_MEMORY_SCOPE_AGENT);
                for (int sp = 0; sp < 400; ++sp) { if (__hip_atomic_load(pc, __ATOMIC_RELAXED, __HIP_MEMORY_SCOPE_AGENT) >= want) break; __builtin_amdgcn_s_sleep(1); }
            }
            __syncthreads();
        }
        f32x2 acc[UP_NT][8];
#pragma unroll
        for (int b = 0; b < UP_NT; ++b)
#pragma unroll
            for (int i = 0; i < 8; ++i) acc[b][i] = (f32x2){0.f, 0.f};
#pragma unroll 1
        for (int c = 0; c < 32; ++c) {
            u32x2 wu[UP_NT][4]; float cf[UP_NT][4];
#pragma unroll
            for (int b = 0; b < UP_NT; ++b)
#pragma unroll
                for (int k = 0; k < 4; ++k) {
                    const int slot = (c & 15) * 4 + k;
                    const int ek = __builtin_amdgcn_readlane(c < 16 ? e_lo[b] : e_hi[b], slot);
                    cf[b][k] = __builtin_bit_cast(float, __builtin_amdgcn_readlane(__builtin_bit_cast(int, c < 16 ? c_lo[b] : c_hi[b]), slot));
                    wu[b][k] = *(const u32x2*)(WUQ + (size_t)ek * (DM / 2) + 8 * lane);
                }
#pragma unroll
            for (int b = 0; b < UP_NT; ++b)
#pragma unroll
                for (int k = 0; k < 4; ++k) {
                    const f32x2 cc = (f32x2){cf[b][k], cf[b][k]};
#pragma unroll
                    for (int q = 0; q < 2; ++q) {
                        const f32x2 v0 = __builtin_amdgcn_cvt_scalef32_pk_f32_fp4(wu[b][k][q], 1.0f, 0), v1 = __builtin_amdgcn_cvt_scalef32_pk_f32_fp4(wu[b][k][q], 1.0f, 1);
                        const f32x2 v2 = __builtin_amdgcn_cvt_scalef32_pk_f32_fp4(wu[b][k][q], 1.0f, 2), v3 = __builtin_amdgcn_cvt_scalef32_pk_f32_fp4(wu[b][k][q], 1.0f, 3);
                        acc[b][4 * q] = cc * v0 + acc[b][4 * q]; acc[b][4 * q + 1] = cc * v1 + acc[b][4 * q + 1];
                        acc[b][4 * q + 2] = cc * v2 + acc[b][4 * q + 2]; acc[b][4 * q + 3] = cc * v3 + acc[b][4 * q + 3];
                    }
                }
        }
#pragma unroll
        for (int b = 0; b < UP_NT; ++b) {
            const int t = t0 + b;
            f32x4 x[4];
            { const u32x4 xa = *(const u32x4*)(X + (size_t)t * DM + 16 * lane), xb2 = *(const u32x4*)(X + (size_t)t * DM + 16 * lane + 8);
              x[0] = (f32x4){bf_lo(xa.x), bf_hi(xa.x), bf_lo(xa.y), bf_hi(xa.y)}; x[1] = (f32x4){bf_lo(xa.z), bf_hi(xa.z), bf_lo(xa.w), bf_hi(xa.w)};
              x[2] = (f32x4){bf_lo(xb2.x), bf_hi(xb2.x), bf_lo(xb2.y), bf_hi(xb2.y)}; x[3] = (f32x4){bf_lo(xb2.z), bf_hi(xb2.z), bf_lo(xb2.w), bf_hi(xb2.w)}; }
            float ss = 0.f;
#pragma unroll
            for (int j = 0; j < 4; ++j) { x[j] = x[j] + (f32x4){acc[b][2 * j][0], acc[b][2 * j][1], acc[b][2 * j + 1][0], acc[b][2 * j + 1][1]};
                ss += (x[j][0] * x[j][0] + x[j][1] * x[j][1]) + (x[j][2] * x[j][2] + x[j][3] * x[j][3]); }
            const float r2 = __builtin_amdgcn_rsqf(wave_sum(ss) * (1.0f / DM) + RMS_EPS);
            if (layer == 0) {
                bf16_t* ox = XO + (size_t)t * DM + 16 * lane; bf16_t* on = XN + (size_t)t * DM + 16 * lane;
                u32x4 w; w.x = cvt_pk_bf16(x[0][0], x[0][1]); w.y = cvt_pk_bf16(x[0][2], x[0][3]); w.z = cvt_pk_bf16(x[1][0], x[1][1]); w.w = cvt_pk_bf16(x[1][2], x[1][3]);
                *(u32x4*)ox = w;
                w.x = cvt_pk_bf16(x[2][0], x[2][1]); w.y = cvt_pk_bf16(x[2][2], x[2][3]); w.z = cvt_pk_bf16(x[3][0], x[3][1]); w.w = cvt_pk_bf16(x[3][2], x[3][3]);
                *(u32x4*)(ox + 8) = w;
                w.x = cvt_pk_bf16(x[0][0] * r2, x[0][1] * r2); w.y = cvt_pk_bf16(x[0][2] * r2, x[0][3] * r2); w.z = cvt_pk_bf16(x[1][0] * r2, x[1][1] * r2); w.w = cvt_pk_bf16(x[1][2] * r2, x[1][3] * r2);
                *(u32x4*)on = w;
                w.x = cvt_pk_bf16(x[2][0] * r2, x[2][1] * r2); w.y = cvt_pk_bf16(x[2][2] * r2, x[2][3] * r2); w.z = cvt_pk_bf16(x[3][0] * r2, x[3][1] * r2); w.w = cvt_pk_bf16(x[3][2] * r2, x[3][3] * r2);
                *(u32x4*)(on + 8) = w;
            } else {
                float* xo = FO + (size_t)t * DM + 16 * lane;
#pragma unroll
                for (int j = 0; j < 4; ++j) { const f32x4 g = *(const f32x4*)(gfin + 16 * lane + 4 * j); *(f32x4*)(xo + 4 * j) = x[j] * r2 * g; }
            }
        }
    }
}

__device__ __forceinline__ void sgu_phase(const Args& A, LAS unsigned char* lds, int vcu, int G, int wave, int lane) {
    const bf16_t* U = (const bf16_t*)(A.ws + WS_PROJ);
    const bf16_t* VT = (const bf16_t*)(A.ws + WS_PROJ) + (size_t)T * DM;
    const float* SQ2 = (const float*)(A.ws + WS_SQ2);
    const bf16_t* WS_ = (const bf16_t*)(A.ws + WS_WS);
    bf16_t* Gt = (bf16_t*)(A.ws + WS_MIX);
    const float* c_norm = A.in[9]; const float* b_s = A.in[11];
    const int fr = lane & 15, fq = lane >> 4, tid = threadIdx.x;
    constexpr int WROW = 272, WBUF = 128 * WROW;
    LAS float* lrs = (LAS float*)(lds + 2 * WBUF);
    for (int ch = vcu; ch < T / 128; ch += G) {
        __syncthreads();
        if (tid < 128) {
            const f32x4* sp = (const f32x4*)(SQ2 + (size_t)(ch * 128 + tid) * 16);
            const f32x4 a = sp[0], b = sp[1], c = sp[2], d = sp[3];
            const float sm = ((a[0] + a[1]) + (a[2] + a[3])) + ((b[0] + b[1]) + (b[2] + b[3])) + ((c[0] + c[1]) + (c[2] + c[3])) + ((d[0] + d[1]) + (d[2] + d[3]));
            lrs[tid] = __builtin_amdgcn_rsqf(sm * (1.0f / DM) + RMS_EPS);
        }
        { const u32x4* wp = (const u32x4*)(WS_ + (size_t)(tid >> 2) * 128 + (tid & 3) * 32);
          LAS u32x4* lp = (LAS u32x4*)(lds + (tid >> 2) * WROW + (tid & 3) * 64);
#pragma unroll
          for (int k = 0; k < 4; ++k) lp[k] = wp[k]; }
        __syncthreads();
#pragma unroll 1
        for (int g = 0; g < 8; ++g) {
            LAS unsigned char* wcur = lds + (g & 1) * WBUF;
            u32x4 wn[4];
            if (g + 1 < 8) { const u32x4* wp = (const u32x4*)(WS_ + (size_t)(g + 1) * 128 * 128 + (size_t)(tid >> 2) * 128 + (tid & 3) * 32);
#pragma unroll
                for (int k = 0; k < 4; ++k) wn[k] = wp[k]; }
            const int c = g * 128 + 16 * wave + fr;
            bf16x8 Vf[4];
#pragma unroll
            for (int s = 0; s < 4; ++s) {
                const u32x4 v = *(const u32x4*)(VT + (size_t)ch * (DM * 128) + (size_t)c * 128 + 32 * s + 8 * fq);
                const f32x4 ra = *(const LAS f32x4*)(lrs + 32 * s + 8 * fq), rb = *(const LAS f32x4*)(lrs + 32 * s + 8 * fq + 4);
                u32x4 w;
                w[0] = cvt_pk_bf16(bf_lo(v[0]) * ra[0], bf_hi(v[0]) * ra[1]); w[1] = cvt_pk_bf16(bf_lo(v[1]) * ra[2], bf_hi(v[1]) * ra[3]);
                w[2] = cvt_pk_bf16(bf_lo(v[2]) * rb[0], bf_hi(v[2]) * rb[1]); w[3] = cvt_pk_bf16(bf_lo(v[3]) * rb[2], bf_hi(v[3]) * rb[3]);
                Vf[s] = __builtin_bit_cast(bf16x8, w);
            }
            const int c0 = g * 128 + 16 * wave + 4 * fq;
            u32x2 uu[8];
#pragma unroll
            for (int pb = 0; pb < 8; ++pb) uu[pb] = *(const u32x2*)(U + (size_t)(ch * 128 + pb * 16 + fr) * DM + c0);
            f32x4 acc[8];
#pragma unroll
            for (int pb = 0; pb < 8; ++pb) acc[pb] = (f32x4){0.f, 0.f, 0.f, 0.f};
#pragma unroll
            for (int s = 0; s < 4; ++s) {
#pragma unroll
                for (int pb = 0; pb < 8; ++pb) {
                    const bf16x8 Wf = *(const LAS bf16x8*)(wcur + (pb * 16 + fr) * WROW + 64 * s + 16 * fq);
                    acc[pb] = __builtin_amdgcn_mfma_f32_16x16x32_bf16(Vf[s], Wf, acc[pb], 0, 0, 0);
                }
                asm volatile("" ::: "memory");
            }
            const f32x4 cn = *(const f32x4*)(c_norm + c0);
#pragma unroll
            for (int pb = 0; pb < 8; ++pb) {
                const int p = pb * 16 + fr;
                const float bs = b_s[g * 128 + p];
                const f32x4 mx = acc[pb] * cn + bs;
                u32x2 w; w.x = cvt_pk_bf16(bf_lo(uu[pb].x) * mx[0], bf_hi(uu[pb].x) * mx[1]); w.y = cvt_pk_bf16(bf_lo(uu[pb].y) * mx[2], bf_hi(uu[pb].y) * mx[3]);
                *(u32x2*)(Gt + (size_t)(ch * 128 + p) * DM + c0) = w;
            }
            if (g + 1 < 8) { LAS u32x4* lp = (LAS u32x4*)(lds + ((g + 1) & 1) * WBUF + (tid >> 2) * WROW + (tid & 3) * 64);
#pragma unroll
                for (int k = 0; k < 4; ++k) lp[k] = wn[k]; }
            __syncthreads();
        }
    }
}

constexpr int NPHASE = 14;
__global__ void __launch_bounds__(NWAVES * 64, 2) mk_fwd(Args args) {
    extern __shared__ __attribute__((aligned(16))) unsigned char lds_raw[];
    LAS unsigned char* lds = (LAS unsigned char*)lds_raw;
    const int tid = threadIdx.x, lane = tid & 63, wave = __builtin_amdgcn_readfirstlane(tid >> 6);
    const int G = gridDim.x; const int bx = blockIdx.x;
    const int vcu = (G % 8 == 0) ? (bx % 8) * (G / 8) + bx / 8 : bx;
    unsigned char* ws = args.ws;
    const int lo = args.ph_lo, hi = args.ph_hi;
#ifndef REP_MASK
#define REP_MASK 0u
#endif
#define REP(k) (((REP_MASK >> (k)) & 1u) != 0u)
#ifndef PH_MASK
#define PH_MASK 0xffffffffu
#endif
#define IN(k) (((PH_MASK >> (k)) & 1u) && lo <= (k) && (k) < hi)
    cg::grid_group grid = cg::this_grid();
    {
        volatile LAS unsigned* stw = (volatile LAS unsigned*)(lds + LDS_BARST);
        if (tid < 2) stw[tid] = 0u;
        __syncthreads();
    }
    const XcdBarrier xbar = xcd_barrier_post((unsigned*)(ws + WS_CTL) + 1024, (volatile LAS unsigned*)(lds + LDS_BARST));
    if (lo < 0) grid.sync();
#define SEAM(k) do { if (IN(k) && IN((k) + 1)) xcd_barrier(xbar); } while (0)
#define RSYNC() xcd_barrier(xbar)
    bf16_t* XA = (bf16_t*)(ws + WS_XA); bf16_t* PROJ = (bf16_t*)(ws + WS_PROJ); bf16_t* MIX = (bf16_t*)(ws + WS_MIX);
    float* SQ = (float*)(ws + WS_SQ); float* SQ2 = (float*)(ws + WS_SQ2);

    if (IN(0)) { if (REP(0)) { p0_prologue(args, lds, vcu, G, wave, lane); RSYNC(); } p0_prologue(args, lds, vcu, G, wave, lane); }
    SEAM(0);
    if (IN(1)) { if (REP(1)) { { pg8::Gemm g{XA, (const bf16_t*)(ws + WS_WABIN), T, 2048, DM}; pg8::StaticOrder S; S.init(T, 2048, G, bx);
        pg8::EpiProj E{PROJ, (const float*)(ws + WS_TAB), SQ}; pg8::gemm_phase(lds, g, S, E); } RSYNC(); } { pg8::Gemm g{XA, (const bf16_t*)(ws + WS_WABIN), T, 2048, DM}; pg8::StaticOrder S; S.init(T, 2048, G, bx);
        pg8::EpiProj E{PROJ, (const float*)(ws + WS_TAB), SQ}; pg8::gemm_phase(lds, g, S, E); } }
    SEAM(1);
    if (IN(2)) { if (REP(2)) { attn_phase(args, lds, vcu, G, wave, lane); RSYNC(); } attn_phase(args, lds, vcu, G, wave, lane); }
    SEAM(2);
    if (IN(3)) { if (REP(3)) { mixab_phase(args, vcu, G, wave, lane); RSYNC(); } mixab_phase(args, vcu, G, wave, lane); }
    SEAM(3);
    if (IN(4)) { if (REP(4)) { { pg8::Gemm g{MIX, (const bf16_t*)(ws + WS_WABOUT), T, 1024, DM}; pg8::StaticOrder S; S.init(T, 1024, G, bx);
        pg8::EpiRes E{nullptr, XA, XA, SQ}; pg8::gemm_phase(lds, g, S, E); } RSYNC(); } { pg8::Gemm g{MIX, (const bf16_t*)(ws + WS_WABOUT), T, 1024, DM}; pg8::StaticOrder S; S.init(T, 1024, G, bx);
        pg8::EpiRes E{nullptr, XA, XA, SQ}; pg8::gemm_phase(lds, g, S, E); } }
    SEAM(4);
    if (IN(5) && REP(19)) { pg8::Gemm g{XA, (const bf16_t*)(ws + WS_WQ0), T, 2048, DM}; pg8::StaticOrder S; S.init(T, 2048, G, bx);
        pg8::EpiScaled E{PROJ, NPROJ, SQ, true, true}; pg8::gemm_phase(lds, g, S, E); RSYNC(); }
    if (IN(5)) { if (REP(5)) { { pg8::Gemm g{XA, (const bf16_t*)(ws + WS_WQ0), T, 2048, DM}; pg8::StaticOrder S; S.init(T, 2048, G, bx);
        pg8::EpiScaled E{PROJ, NPROJ, SQ, false, true}; pg8::gemm_phase(lds, g, S, E); } RSYNC(); } { pg8::Gemm g{XA, (const bf16_t*)(ws + WS_WQ0), T, 2048, DM}; pg8::StaticOrder S; S.init(T, 2048, G, bx);
        pg8::EpiScaled E{PROJ, NPROJ, SQ, false, true}; pg8::gemm_phase(lds, g, S, E); } }
    SEAM(5);
    if (IN(6)) { if (REP(6)) { topk_phase(args, lds, 0, vcu, G, wave, lane); RSYNC(); } topk_phase(args, lds, 0, vcu, G, wave, lane); }
    SEAM(6);
    if (IN(7)) { if (REP(7)) { expert_up_phase(args, lds, 0, vcu, G, wave, lane, true); RSYNC(); } if (REP(14)) { expert_down_phase(args, lds, 0, G, bx, wave, lane, 1); RSYNC(); } if (REP(15)) { expert_down_phase(args, lds, 0, G, bx, wave, lane, 2); RSYNC(); } if (REP(16)) { expert_down_phase(args, lds, 0, G, bx, wave, lane, 5); RSYNC(); } if (REP(17)) { expert_down_phase(args, lds, 0, G, bx, wave, lane, 3); RSYNC(); } if (REP(18)) { expert_down_phase(args, lds, 0, G, bx, wave, lane, 6); RSYNC(); } expert_down_phase(args, lds, 0, G, bx, wave, lane); RSYNC(); expert_up_phase(args, lds, 0, vcu, G, wave, lane, false, xbar.st[0]); }
    SEAM(7);
    if (IN(8)) { if (REP(8)) { { pg8::Gemm g{(const bf16_t*)(ws + WS_OP), (const bf16_t*)(ws + WS_WCIN), T, 2048, DM}; pg8::StaticOrder S; S.init(T, 2048, G, bx);
        pg8::EpiGelu E{PROJ, PROJ + (size_t)T * DM, SQ2}; pg8::gemm_phase(lds, g, S, E); } RSYNC(); } { pg8::Gemm g{(const bf16_t*)(ws + WS_OP), (const bf16_t*)(ws + WS_WCIN), T, 2048, DM}; pg8::StaticOrder S; S.init(T, 2048, G, bx);
        pg8::EpiGelu E{PROJ, PROJ + (size_t)T * DM, SQ2}; pg8::gemm_phase(lds, g, S, E); } }
    SEAM(8);
    if (IN(9)) { if (REP(9)) { sgu_phase(args, lds, vcu, G, wave, lane); RSYNC(); } sgu_phase(args, lds, vcu, G, wave, lane); }
    SEAM(9);
    if (IN(10)) { if (REP(10)) { { pg8::Gemm g{MIX, (const bf16_t*)(ws + WS_WCOUT), T, 1024, DM}; pg8::StaticOrder S; S.init(T, 1024, G, bx);
        pg8::EpiRes E{nullptr, XA, XA, SQ}; pg8::gemm_phase(lds, g, S, E); } RSYNC(); } { pg8::Gemm g{MIX, (const bf16_t*)(ws + WS_WCOUT), T, 1024, DM}; pg8::StaticOrder S; S.init(T, 1024, G, bx);
        pg8::EpiRes E{nullptr, XA, XA, SQ}; pg8::gemm_phase(lds, g, S, E); } }
    SEAM(10);
    if (IN(11)) { if (REP(11)) { { pg8::Gemm g{XA, (const bf16_t*)(ws + WS_WQ1), T, 2048, DM}; pg8::StaticOrder S; S.init(T, 2048, G, bx);
        pg8::EpiScaled E{PROJ, NPROJ, SQ, false, true}; pg8::gemm_phase(lds, g, S, E); } RSYNC(); } { pg8::Gemm g{XA, (const bf16_t*)(ws + WS_WQ1), T, 2048, DM}; pg8::StaticOrder S; S.init(T, 2048, G, bx);
        pg8::EpiScaled E{PROJ, NPROJ, SQ, false, true}; pg8::gemm_phase(lds, g, S, E); } }
    SEAM(11);
    if (IN(12)) { if (REP(12)) { topk_phase(args, lds, 1, vcu, G, wave, lane); RSYNC(); } topk_phase(args, lds, 1, vcu, G, wave, lane); }
    SEAM(12);
    if (IN(13)) { if (REP(13)) { expert_up_phase(args, lds, 1, vcu, G, wave, lane, true); RSYNC(); } expert_down_phase(args, lds, 1, G, bx, wave, lane); RSYNC(); expert_up_phase(args, lds, 1, vcu, G, wave, lane, false, xbar.st[0]); }
#undef IN
#undef SEAM
}

extern "C" void kernel_launch(void* const* d_in, const int* in_sizes, int n_in, void* d_out, int out_size, void* d_ws, size_t ws_size, hipStream_t stream) {
    static int grid = 0;
    if (grid == 0) {
        if (n_in != 17 || in_sizes[0] != T * DM || out_size != T * DM || ws_size < WS_END) {
            fprintf(stderr, "kernel_launch: unexpected shapes: n_in %d in0 %d out %d ws %zu (need %zu)\n", n_in, n_in > 0 ? in_sizes[0] : -1, out_size, ws_size, (size_t)WS_END); grid = -1; return; }
        int dev = 0, cus = 0, per_cu = 0;
        hipGetDevice(&dev);
        hipDeviceGetAttribute(&cus, hipDeviceAttributeMultiprocessorCount, dev);
        hipFuncSetAttribute((const void*)mk_fwd, hipFuncAttributeMaxDynamicSharedMemorySize, LDS_BYTES);
        hipOccupancyMaxActiveBlocksPerMultiprocessor(&per_cu, (const void*)mk_fwd, NWAVES * 64, LDS_BYTES);
        if (per_cu < 1) { fprintf(stderr, "kernel_launch: occupancy query says %d blocks per CU\n", per_cu); per_cu = 1; }
        (void)hipGetLastError();
        grid = cus;
    }
    if (grid < 0) return;
    if (hipMemsetAsync((char*)d_ws + WS_CTL, 0, 64 * 1024, stream) != hipSuccess) { fprintf(stderr, "kernel_launch: memset of control words failed\n"); return; }
    Args a{};
    for (int i = 0; i < 17; ++i) a.in[i] = (const float*)d_in[i];
    a.out = (float*)d_out; a.ws = (unsigned char*)d_ws;
    a.ph_lo = 0; a.ph_hi = NPHASE;
    void* kargs[] = {&a};
    hipError_t e = hipLaunchCooperativeKernel((const void*)mk_fwd, dim3(grid), dim3(NWAVES * 64), kargs, LDS_BYTES, stream);
    if (e != hipSuccess) fprintf(stderr, "cooperative launch failed: %s (grid %d)\n", hipGetErrorString(e), grid);
}
```

```cpp
#include <hip/hip_runtime.h>
#include <hip/hip_cooperative_groups.h>
#include <cstdio>
#include <cstdint>
namespace cg = cooperative_groups;


constexpr int BATCH = 32, SEQ = 2048, DM = 1024, T = BATCH * SEQ;
constexpr int NPROJ = 2048;
constexpr float RMS_EPS = 1e-6f;
constexpr float LOG2E = 1.4426950408889634f;
constexpr float QSCALE = 0.125f * LOG2E;
constexpr int NEXP = 16384;

constexpr size_t MiB = 1u << 20;
constexpr size_t WS_CTL = 0;
constexpr size_t WS_TAB = 1 * MiB;
constexpr size_t WS_SQ = 2 * MiB;
constexpr size_t WS_SQ2 = 6 * MiB;
constexpr size_t WS_WPOOL = 10 * MiB;
constexpr size_t WS_WS = 10 * MiB + 512 * 1024;
constexpr size_t WS_SK = 11 * MiB;
constexpr size_t WS_WABIN = 12 * MiB, WS_WABOUT = 16 * MiB, WS_WCIN = 18 * MiB, WS_WCOUT = 22 * MiB, WS_WQ0 = 24 * MiB, WS_WQ1 = 28 * MiB;
constexpr size_t WS_WDQ = 32 * MiB;
constexpr size_t WS_WUQ = 64 * MiB;
constexpr size_t WS_SDU = 96 * MiB;
constexpr size_t WS_XS = 97 * MiB;
constexpr size_t WS_XQ = 936 * MiB;
constexpr size_t WS_XA = 160 * MiB;
constexpr size_t WS_PROJ = 288 * MiB;
constexpr size_t WS_MIX = 544 * MiB;
constexpr size_t WS_EXP = 672 * MiB;
constexpr size_t WS_GATE = 704 * MiB;
constexpr size_t WS_OP = 736 * MiB;
constexpr size_t WS_LSE = 928 * MiB;
constexpr size_t WS_END = 1000 * MiB;

#define LAS __attribute__((address_space(3)))
typedef unsigned short bf16_t;
typedef short bf16x8 __attribute__((ext_vector_type(8)));
typedef short s16x4 __attribute__((ext_vector_type(4)));
typedef float f32x2 __attribute__((ext_vector_type(2)));
typedef float f32x4 __attribute__((ext_vector_type(4)));
typedef float f32x16 __attribute__((ext_vector_type(16)));
typedef unsigned u32x2 __attribute__((ext_vector_type(2)));
typedef unsigned u32x4 __attribute__((ext_vector_type(4)));
typedef __bf16 bf16x2_t __attribute__((ext_vector_type(2)));

__device__ __forceinline__ unsigned cvt_pk_bf16(float lo, float hi) { unsigned r; asm volatile("v_cvt_pk_bf16_f32 %0, %1, %2" : "=v"(r) : "v"(lo), "v"(hi)); return r; }
__device__ __forceinline__ float bf_lo(unsigned w) { return __uint_as_float(w << 16); }
__device__ __forceinline__ float bf_hi(unsigned w) { return __uint_as_float(w & 0xffff0000u); }
__device__ __forceinline__ float dot2_bf16(unsigned w, unsigned x, float acc) { return __builtin_amdgcn_fdot2_f32_bf16(__builtin_bit_cast(bf16x2_t, w), __builtin_bit_cast(bf16x2_t, x), acc, false); }
__device__ __forceinline__ float wave_sum(float v) {
#pragma unroll
    for (int o = 1; o < 64; o <<= 1) v += __shfl_xor(v, o);
    return v;
}
__device__ __forceinline__ float gelu_tanh(float x) {
    const float u = x * (0.7978845608028654f + 0.035677408136300125f * x * x);
    const float e = __builtin_amdgcn_exp2f(-2.0f * LOG2E * u);
    return x * __builtin_amdgcn_rcpf(1.0f + e);
}

namespace pg8 {
constexpr int BM = 256, BK = 64, HALF = 128, HTB = HALF * BK * 2, STAGE_BYTES = 8 * HTB, NXCD = 8, WGM = 8;
__host__ __device__ __forceinline__ int lds_byte(int r, int c) { const int st = (r >> 4) * 2 + (c >> 5), rr = r & 15, cc = c & 31, ob = rr * 64 + cc * 2; return st * 1024 + (ob ^ (((ob >> 9) & 1) << 5)); }
__host__ __device__ __forceinline__ void stage_rc(int b, int& R, int& C) { const int st = b / 1024, sb = b % 1024, swz = sb ^ (((sb >> 9) & 1) << 5); R = (st >> 1) * 16 + swz / 64; C = (st & 1) * 32 + (swz % 64) / 2; }
__host__ __device__ __forceinline__ int perm32(int rho) { const int n = rho >> 4, i = rho & 15; return 8 * (i >> 2) + 4 * n + (i & 3); }

struct Unit { int pm, pn; };
struct Gemm { const bf16_t* A; const bf16_t* Bt; int M, N, K; };

struct StaticOrder {
    int nM, nN, nwg, G, c;
    __host__ __device__ void init(int M, int N, int G_, int c_) { nM = M / BM; nN = N / BM; nwg = nM * nN; G = G_; c = c_; }
    __host__ __device__ bool next(int i, Unit& u) const {
        const long L = (long)i * G + c; if (L >= nwg) return false;
        int wgid = (int)L; { const int q = nwg / NXCD, r = nwg % NXCD, xcd = wgid % NXCD, off = wgid / NXCD; wgid = (xcd < r ? xcd * (q + 1) : r * (q + 1) + (xcd - r) * q) + off; }
        const int nig = WGM * nN, gid = wgid / nig, fm = gid * WGM, gsz = (nM - fm) < WGM ? (nM - fm) : WGM;
        u.pm = fm + ((wgid % nig) % gsz); u.pn = (wgid % nig) / gsz; return true;
    }
};

template <class Epi>
__device__ __forceinline__ void gemm_phase(LAS unsigned char* lds, const Gemm g, const StaticOrder& S, const Epi& E) {
    const int tid = threadIdx.x, wid = __builtin_amdgcn_readfirstlane(tid >> 6), lane = tid & 63, wr = wid >> 2, wc = wid & 3, fr = lane & 15, fq = lane >> 4;
    const int K = g.K, nt = K / BK;
    unsigned voffA[2], voffB[2];
#pragma unroll
    for (int i = 0; i < 2; ++i) { int R, C; stage_rc(tid * 16 + i * 8192, R, C); const int Rb = (R & ~31) + perm32(R & 31);
        voffA[i] = (unsigned)(R * K + C) * 2u; voffB[i] = (unsigned)(Rb * K + C) * 2u; }
    const size_t kstep = (size_t)(BK * 2);
    const size_t hstep = (size_t)HALF * K * 2;
    const size_t tstep = 2 * hstep;
    const unsigned ldsw = (unsigned)wid * 1024u;
    const int aoff = lds_byte(wr * 64 + fr, fq * 8), boff = lds_byte(wc * 32 + fr, fq * 8);
#define PG8_SA(b, h) (((b) * 2 + (h)) * HTB)
#define PG8_SB(b, h) ((4 + (b) * 2 + (h)) * HTB)
#define PG8_STAGE(bufoff, gbase, voff) do { _Pragma("unroll") for (int _i = 0; _i < 2; ++_i) \
        __builtin_amdgcn_global_load_lds((const unsigned*)((const char*)(gbase) + (voff)[_i]), (LAS unsigned*)(lds + (bufoff) + ldsw + _i * 8192), 16, 0, 0); } while (0)
#define PG8_LDA(dst, b, h) do { _Pragma("unroll") for (int m = 0; m < 4; ++m) _Pragma("unroll") for (int k = 0; k < 2; ++k) dst[m][k] = *(const LAS bf16x8*)(lds + PG8_SA(b, h) + aoff + m * 2048 + k * 1024); } while (0)
#define PG8_LDB(dst, b, h) do { _Pragma("unroll") for (int n = 0; n < 2; ++n) _Pragma("unroll") for (int k = 0; k < 2; ++k) dst[n][k] = *(const LAS bf16x8*)(lds + PG8_SB(b, h) + boff + n * 2048 + k * 1024); } while (0)
#define PG8_MMA(ai, bj, At, Bt) do { __builtin_amdgcn_s_setprio(1); _Pragma("unroll") for (int m = 0; m < 4; ++m) _Pragma("unroll") for (int n = 0; n < 2; ++n) _Pragma("unroll") for (int k = 0; k < 2; ++k) \
        acc[ai][bj][m][n] = __builtin_amdgcn_mfma_f32_16x16x32_bf16(Bt[n][k], At[m][k], acc[ai][bj][m][n], 0, 0, 0); __builtin_amdgcn_s_setprio(0); } while (0)
#define PG8_WAIT_V(n) asm volatile("s_waitcnt vmcnt(" #n ")" ::: "memory")
#define PG8_WAIT_L(n) asm volatile("s_waitcnt lgkmcnt(" #n ")" ::: "memory")
#define PG8_BAR __builtin_amdgcn_s_barrier()
#define PG8_SCHED __builtin_amdgcn_sched_barrier(0)
    Unit cur, nxt; int ui = 0;
    if (!S.next(0, cur)) return;
    f32x4 acc[2][2][4][2];
#pragma unroll
    for (int a = 0; a < 2; ++a)
#pragma unroll
        for (int b = 0; b < 2; ++b)
#pragma unroll
            for (int m = 0; m < 4; ++m)
#pragma unroll
                for (int n = 0; n < 2; ++n) acc[a][b][m][n] = (f32x4){0.f, 0.f, 0.f, 0.f};
    bf16x8 At[4][2], B0[2][2], B1[2][2];
    const char* cA = (const char*)g.A + (size_t)cur.pm * tstep; const char* cB = (const char*)g.Bt + (size_t)cur.pn * tstep;
    PG8_STAGE(PG8_SB(0, 0), cB, voffB); PG8_STAGE(PG8_SB(0, 1), cB + hstep, voffB); PG8_STAGE(PG8_SA(0, 0), cA, voffA); PG8_STAGE(PG8_SA(0, 1), cA + hstep, voffA);
    if (wr == 1) PG8_BAR;
    PG8_WAIT_V(2); PG8_BAR;
    PG8_STAGE(PG8_SB(1, 0), cB + kstep, voffB); PG8_STAGE(PG8_SA(1, 0), cA + kstep, voffA); PG8_STAGE(PG8_SB(1, 1), cB + hstep + kstep, voffB);
    PG8_WAIT_V(6); PG8_BAR;
    for (;;) {
        const bool has_next = S.next(ui + 1, nxt);
        const char* nA = has_next ? (const char*)g.A + (size_t)nxt.pm * tstep : cA; const char* nB = has_next ? (const char*)g.Bt + (size_t)nxt.pn * tstep : cB;
        for (int t = 0; t < nt; t += 2) {
            const bool last = (t == nt - 2);
            const char* a1 = cA + (size_t)(t + 1) * kstep;
            const char* a2 = last ? nA : cA + (size_t)(t + 2) * kstep; const char* b2 = last ? nB : cB + (size_t)(t + 2) * kstep;
            const char* a3 = a2 + kstep; const char* b3 = b2 + kstep;
            PG8_LDB(B0, 0, 0); PG8_LDB(B1, 0, 1); PG8_SCHED; PG8_LDA(At, 0, 0); PG8_STAGE(PG8_SA(1, 1), a1 + hstep, voffA);
            PG8_WAIT_V(8); PG8_WAIT_L(0); PG8_BAR; PG8_MMA(0, 0, At, B0); PG8_MMA(0, 1, At, B1); PG8_BAR; PG8_SCHED;
            PG8_LDA(At, 0, 1); PG8_STAGE(PG8_SB(0, 0), b2, voffB); PG8_STAGE(PG8_SB(0, 1), b2 + hstep, voffB); PG8_STAGE(PG8_SA(0, 0), a2, voffA);
            PG8_WAIT_V(8); PG8_WAIT_L(0); PG8_BAR; PG8_MMA(1, 0, At, B0); PG8_MMA(1, 1, At, B1); PG8_BAR; PG8_SCHED;
            PG8_LDB(B0, 1, 0); PG8_LDB(B1, 1, 1); PG8_SCHED; PG8_LDA(At, 1, 0); PG8_STAGE(PG8_SA(0, 1), a2 + hstep, voffA);
            PG8_WAIT_V(8); PG8_WAIT_L(0); PG8_BAR; PG8_MMA(0, 0, At, B0); PG8_MMA(0, 1, At, B1); PG8_BAR; PG8_SCHED;
            PG8_LDA(At, 1, 1); PG8_STAGE(PG8_SB(1, 0), b3, voffB); PG8_STAGE(PG8_SB(1, 1), b3 + hstep, voffB); PG8_STAGE(PG8_SA(1, 0), a3, voffA);
            PG8_WAIT_V(8); PG8_WAIT_L(0); PG8_BAR; PG8_MMA(1, 0, At, B0); PG8_MMA(1, 1, At, B1); PG8_BAR; PG8_SCHED;
        }
        if (wr == 0) PG8_BAR;
        E(acc, cur, wr, wc, fr, fq);
        if (!has_next) break;
#pragma unroll
        for (int a = 0; a < 2; ++a)
#pragma unroll
            for (int b = 0; b < 2; ++b)
#pragma unroll
                for (int m = 0; m < 4; ++m)
#pragma unroll
                    for (int n = 0; n < 2; ++n) acc[a][b][m][n] = (f32x4){0.f, 0.f, 0.f, 0.f};
        cur = nxt; cA = nA; cB = nB; ++ui;
        if (wr == 1) PG8_BAR;
    }
    PG8_WAIT_V(0);
    PG8_BAR;
#undef PG8_SA
#undef PG8_SB
#undef PG8_STAGE
#undef PG8_LDA
#undef PG8_LDB
#undef PG8_MMA
#undef PG8_WAIT_V
#undef PG8_WAIT_L
#undef PG8_BAR
#undef PG8_SCHED
}

struct EpiProj {
    bf16_t* O; const float* tab;
    __device__ __forceinline__ void operator()(const f32x4 (&acc)[2][2][4][2], const Unit& u, int wr, int wc, int fr, int fq) const {
        const int row0 = u.pm * BM + wr * 64 + fr, col0 = u.pn * BM + wc * 32 + 8 * fq;
        const bool rot = (u.pn < 4) && ((wc & 1) == 0);
        const float sc = (u.pn < 2) ? QSCALE : 1.f;
#pragma unroll
        for (int ai = 0; ai < 2; ++ai)
#pragma unroll
            for (int m = 0; m < 4; ++m) {
                const int row = row0 + ai * HALF + m * 16;
                bf16_t* rowp = O + (size_t)row * NPROJ + col0;
                f32x4 t0, t1, t2, t3;
                if (rot) { const f32x4* tp = (const f32x4*)(tab + (size_t)(row & (SEQ - 1)) * 16); t0 = tp[0]; t1 = tp[1]; t2 = tp[2]; t3 = tp[3]; }
#pragma unroll
                for (int bj = 0; bj < 2; ++bj) {
                    f32x4 v0 = acc[ai][bj][m][0], v1 = acc[ai][bj][m][1];
                    if (rot) {
                        f32x4 p0, p1;
#pragma unroll
                        for (int j = 0; j < 4; ++j) { p0[j] = __shfl_xor(v0[j], 16); p1[j] = __shfl_xor(v1[j], 16); }
                        const float sg = (fq == 0) ? -1.f : ((fq == 1) ? 1.f : 0.f);
                        const bool on = fq < 2;
                        const float c0 = on ? t0[0] : 1.f, s0 = sg * t0[1], c1 = on ? t0[2] : 1.f, s1 = sg * t0[3];
                        const float c2 = on ? t1[0] : 1.f, s2 = sg * t1[1], c3 = on ? t1[2] : 1.f, s3 = sg * t1[3];
                        const float c4 = on ? t2[0] : 1.f, s4 = sg * t2[1], c5 = on ? t2[2] : 1.f, s5 = sg * t2[3];
                        const float c6 = on ? t3[0] : 1.f, s6 = sg * t3[1], c7 = on ? t3[2] : 1.f, s7 = sg * t3[3];
                        v0[0] = v0[0] * c0 + p0[0] * s0; v0[1] = v0[1] * c1 + p0[1] * s1; v0[2] = v0[2] * c2 + p0[2] * s2; v0[3] = v0[3] * c3 + p0[3] * s3;
                        v1[0] = v1[0] * c4 + p1[0] * s4; v1[1] = v1[1] * c5 + p1[1] * s5; v1[2] = v1[2] * c6 + p1[2] * s6; v1[3] = v1[3] * c7 + p1[3] * s7;
                    }
                    v0 = v0 * sc; v1 = v1 * sc;
                    u32x4 w; w.x = cvt_pk_bf16(v0[0], v0[1]); w.y = cvt_pk_bf16(v0[2], v0[3]); w.z = cvt_pk_bf16(v1[0], v1[1]); w.w = cvt_pk_bf16(v1[2], v1[3]);
                    *(u32x4*)(rowp + bj * HALF) = w;
                }
            }
    }
};
struct EpiRes {
    const float* basef; const bf16_t* baseb; bf16_t* xb; float* sq;
    __device__ __forceinline__ void operator()(const f32x4 (&acc)[2][2][4][2], const Unit& u, int wr, int wc, int fr, int fq) const {
        const int row0 = u.pm * BM + wr * 64 + fr, col0 = u.pn * BM + wc * 32 + 8 * fq;
#pragma unroll
        for (int ai = 0; ai < 2; ++ai)
#pragma unroll
            for (int m = 0; m < 4; ++m) {
                const int row = row0 + ai * HALF + m * 16;
                const size_t off = (size_t)row * DM + col0;
                float ss = 0.f;
#pragma unroll
                for (int bj = 0; bj < 2; ++bj) {
                    f32x4 b0, b1;
                    if (basef) { b0 = *(const f32x4*)(basef + off + bj * HALF); b1 = *(const f32x4*)(basef + off + bj * HALF + 4); }
                    else { const u32x4 bb = *(const u32x4*)(baseb + off + bj * HALF);
                        b0 = (f32x4){bf_lo(bb.x), bf_hi(bb.x), bf_lo(bb.y), bf_hi(bb.y)}; b1 = (f32x4){bf_lo(bb.z), bf_hi(bb.z), bf_lo(bb.w), bf_hi(bb.w)}; }
                    const f32x4 o0 = b0 + acc[ai][bj][m][0], o1 = b1 + acc[ai][bj][m][1];
                    u32x4 w; w.x = cvt_pk_bf16(o0[0], o0[1]); w.y = cvt_pk_bf16(o0[2], o0[3]); w.z = cvt_pk_bf16(o1[0], o1[1]); w.w = cvt_pk_bf16(o1[2], o1[3]);
                    *(u32x4*)(xb + off + bj * HALF) = w;
                    ss += (o0[0] * o0[0] + o0[1] * o0[1]) + (o0[2] * o0[2] + o0[3] * o0[3]) + (o1[0] * o1[0] + o1[1] * o1[1]) + (o1[2] * o1[2] + o1[3] * o1[3]);
                }
                ss += __shfl_xor(ss, 16); ss += __shfl_xor(ss, 32);
                if (fq == 0) sq[(size_t)row * 16 + u.pn * 4 + wc] = ss;
            }
    }
};
struct EpiScaled {
    bf16_t* O; int ldc; const float* sq; bool plain; bool frag;
    __device__ __forceinline__ void operator()(const f32x4 (&acc)[2][2][4][2], const Unit& u, int wr, int wc, int fr, int fq) const {
        const int row0 = u.pm * BM + wr * 64 + fr, col0 = u.pn * BM + wc * 32 + 8 * fq;
#pragma unroll
        for (int ai = 0; ai < 2; ++ai)
#pragma unroll
            for (int m = 0; m < 4; ++m) {
                const int row = row0 + ai * HALF + m * 16;
                float rstd = 1.f;
                if (!plain) {
                const f32x4* sp = (const f32x4*)(sq + (size_t)row * 16);
                const f32x4 a = sp[0], b = sp[1], c = sp[2], d = sp[3];
                const float s = ((a[0] + a[1]) + (a[2] + a[3])) + ((b[0] + b[1]) + (b[2] + b[3])) + ((c[0] + c[1]) + (c[2] + c[3])) + ((d[0] + d[1]) + (d[2] + d[3]));
                rstd = __builtin_amdgcn_rsqf(s * (1.0f / DM) + RMS_EPS);
                }
                bf16_t* rowp = O + (size_t)row * ldc + col0;
#pragma unroll
                for (int bj = 0; bj < 2; ++bj) {
                    const f32x4 v0 = acc[ai][bj][m][0] * rstd, v1 = acc[ai][bj][m][1] * rstd;
                    u32x4 w; w.x = cvt_pk_bf16(v0[0], v0[1]); w.y = cvt_pk_bf16(v0[2], v0[3]); w.z = cvt_pk_bf16(v1[0], v1[1]); w.w = cvt_pk_bf16(v1[2], v1[3]);
                    if (frag) {
                        const int c = col0 + bj * HALF, h = c >> 8, half = (c >> 7) & 1, hh = (c >> 6) & 1, s = (c >> 3) & 7;
                        const size_t chunk = ((((size_t)(row >> 5) * 8 + h) * 2 + half) * 8 + s) * 64 + (row & 31) + 32 * hh;
                        *(u32x4*)(O + chunk * 8) = w;
                    } else *(u32x4*)(rowp + bj * HALF) = w;
                }
            }
    }
};
struct EpiGelu {
    bf16_t* U; bf16_t* VT; float* sq2;
    __device__ __forceinline__ void operator()(const f32x4 (&acc)[2][2][4][2], const Unit& u, int wr, int wc, int fr, int fq) const {
        const int row0 = u.pm * BM + wr * 64 + fr;
        if (u.pn < 4) {
            const int col0 = u.pn * BM + wc * 32 + 8 * fq;
#pragma unroll
            for (int ai = 0; ai < 2; ++ai)
#pragma unroll
                for (int m = 0; m < 4; ++m) {
                    const int row = row0 + ai * HALF + m * 16;
                    bf16_t* rowp = U + (size_t)row * DM + col0;
#pragma unroll
                    for (int bj = 0; bj < 2; ++bj) {
                        const f32x4 a0 = acc[ai][bj][m][0], a1 = acc[ai][bj][m][1];
                        u32x4 w; w.x = cvt_pk_bf16(gelu_tanh(a0[0]), gelu_tanh(a0[1])); w.y = cvt_pk_bf16(gelu_tanh(a0[2]), gelu_tanh(a0[3]));
                        w.z = cvt_pk_bf16(gelu_tanh(a1[0]), gelu_tanh(a1[1])); w.w = cvt_pk_bf16(gelu_tanh(a1[2]), gelu_tanh(a1[3]));
                        *(u32x4*)(rowp + bj * HALF) = w;
                    }
                }
        } else {
            const int col0 = (u.pn - 4) * BM + wc * 32 + 8 * fq;
#pragma unroll
            for (int ai = 0; ai < 2; ++ai)
#pragma unroll
                for (int m = 0; m < 4; ++m) {
                    const int row = row0 + ai * HALF + m * 16;
                    bf16_t* vp = VT + (size_t)(row >> 7) * (DM * 128) + (row & 127);
                    float ss = 0.f;
#pragma unroll
                    for (int bj = 0; bj < 2; ++bj) {
#pragma unroll
                        for (int n = 0; n < 2; ++n)
#pragma unroll
                            for (int j = 0; j < 4; ++j) {
                                const float g = gelu_tanh(acc[ai][bj][m][n][j]);
                                ss += g * g;
                                vp[(size_t)(col0 + bj * HALF + 4 * n + j) * 128] = (bf16_t)(cvt_pk_bf16(g, 0.f) & 0xffffu);
                            }
                    }
                    ss += __shfl_xor(ss, 16); ss += __shfl_xor(ss, 32);
                    if (fq == 0) sq2[(size_t)row * 16 + (u.pn - 4) * 4 + wc] = ss;
                }
        }
    }
};
}

constexpr int RING_BYTES = 131072;
constexpr int LDS_BYTES = 147456;
constexpr int LDS_BARST = LDS_BYTES - 64;
constexpr int NWAVES = 8;

struct Args { const float* in[17]; float* out; unsigned char* ws; int ph_lo, ph_hi; };

__device__ __forceinline__ void p0_transpose_item(const float* W, int K, int N, bf16_t* WT, const float* gk, const float* gn, LAS float* scr, int item, int lane) {
    const int nblk = N / 32, kb = item / nblk, nb = item % nblk, k0 = 64 * kb, n0 = 32 * nb;
#pragma unroll 8
    for (int i = 0; i < 32; ++i) { const int kk = 2 * i + (lane >> 5); float v = W[(size_t)(k0 + kk) * N + n0 + (lane & 31)];
        if (gk) v *= gk[k0 + kk]; if (gn) v *= gn[n0 + (lane & 31)]; scr[kk * 33 + (lane & 31)] = v; }
    asm volatile("s_waitcnt lgkmcnt(0)" ::: "memory");
    const int c = lane & 7;
#pragma unroll
    for (int j = 0; j < 4; ++j) { const int n = (lane >> 3) + 8 * j; const LAS float* s = scr + (8 * c) * 33 + n;
        u32x4 o; o.x = cvt_pk_bf16(s[0 * 33], s[1 * 33]); o.y = cvt_pk_bf16(s[2 * 33], s[3 * 33]); o.z = cvt_pk_bf16(s[4 * 33], s[5 * 33]); o.w = cvt_pk_bf16(s[6 * 33], s[7 * 33]);
        *(u32x4*)(WT + (size_t)(n0 + n) * K + k0 + 8 * c) = o; }
    asm volatile("s_waitcnt lgkmcnt(0)" ::: "memory");
}
__device__ __forceinline__ void p0_convert(const float* src, bf16_t* dst, size_t n, const float* gain, size_t gw, size_t ngw, int lane) {
    const size_t nvec = n / 8;
    for (size_t i = gw * 64 + lane; i < nvec; i += ngw * 64) {
        f32x4 a = *(const f32x4*)(src + i * 8), b = *(const f32x4*)(src + i * 8 + 4);
        if (gain) { const size_t c = (i * 8) & 1023; const f32x4 ga = *(const f32x4*)(gain + c), gb = *(const f32x4*)(gain + c + 4); a = a * ga; b = b * gb; }
        u32x4 w; w.x = cvt_pk_bf16(a[0], a[1]); w.y = cvt_pk_bf16(a[2], a[3]); w.z = cvt_pk_bf16(b[0], b[1]); w.w = cvt_pk_bf16(b[2], b[3]);
        *(u32x4*)(dst + i * 8) = w;
    }
}
__device__ __forceinline__ void rms_row_to_bf16(const float* xrow, bf16_t* orow, int lane) {
    const f32x4* xr = (const f32x4*)xrow + lane;
    f32x4 v[4]; float s = 0.f;
#pragma unroll
    for (int j = 0; j < 4; ++j) { v[j] = xr[64 * j]; s += (v[j][0] * v[j][0] + v[j][1] * v[j][1]) + (v[j][2] * v[j][2] + v[j][3] * v[j][3]); }
    const float rstd = __builtin_amdgcn_rsqf(wave_sum(s) * (1.0f / DM) + RMS_EPS);
    u32x2* o8 = (u32x2*)orow + lane;
#pragma unroll
    for (int j = 0; j < 4; ++j) { u32x2 w; w.x = cvt_pk_bf16(v[j][0] * rstd, v[j][1] * rstd); w.y = cvt_pk_bf16(v[j][2] * rstd, v[j][3] * rstd); o8[64 * j] = w; }
}

__device__ __forceinline__ void p0_prologue(const Args& A, LAS unsigned char* lds, int vcu, int G, int wave, int lane) {
    unsigned char* ws = A.ws;
    LAS float* scr = (LAS float*)(lds + wave * 16384);
    const int gw = vcu * NWAVES + wave, NGW = G * NWAVES;
    const float* norm_mix = A.in[1]; const float* norm_ffn = A.in[2];
    constexpr int I_2048 = (DM / 64) * (2048 / 32), I_1024 = (DM / 64) * (1024 / 32), I_POOL = (128 / 64) * (128 / 32);
    constexpr int NITEMS = 4 * I_2048 + 2 * I_1024 + 4 * I_POOL;
    for (int it = gw; it < NITEMS; it += NGW) {
        int r = it;
        if (r < I_2048) { p0_transpose_item(A.in[4], DM, 2048, (bf16_t*)(ws + WS_WABIN), norm_mix, nullptr, scr, r, lane); continue; } r -= I_2048;
        if (r < I_2048) { p0_transpose_item(A.in[8], DM, 2048, (bf16_t*)(ws + WS_WCIN), norm_mix + DM, nullptr, scr, r, lane); continue; } r -= I_2048;
        if (r < I_2048) { p0_transpose_item(A.in[13], DM, 2048, (bf16_t*)(ws + WS_WQ0), norm_ffn, nullptr, scr, r, lane); continue; } r -= I_2048;
        if (r < I_2048) { p0_transpose_item(A.in[13] + (size_t)DM * 2048, DM, 2048, (bf16_t*)(ws + WS_WQ1), norm_ffn + DM, nullptr, scr, r, lane); continue; } r -= I_2048;
        if (r < I_1024) { p0_transpose_item(A.in[5], DM, 1024, (bf16_t*)(ws + WS_WABOUT), nullptr, nullptr, scr, r, lane); continue; } r -= I_1024;
        if (r < I_1024) { p0_transpose_item(A.in[12], DM, 1024, (bf16_t*)(ws + WS_WCOUT), nullptr, nullptr, scr, r, lane); continue; } r -= I_1024;
        { const int g = r / I_POOL, ri = r % I_POOL;
          p0_transpose_item(A.in[6] + (size_t)g * 128 * 128, 128, 128, (bf16_t*)(ws + WS_WPOOL) + (size_t)g * 128 * 128, nullptr, A.in[7] + g * 128, scr, ri, lane); }
    }
    for (int ch = gw * 64 + lane; ch < 2 * 8 * 2 * 4 * 8 * 64; ch += NGW * 64) {
        const int ln = ch & 63, s = (ch >> 6) & 7, kb = (ch >> 9) & 3, hi = ch >> 11;
        const float* sp = A.in[14] + ((size_t)hi * 128 + kb * 32 + (ln & 31)) * 128 + 64 * (ln >> 5) + 8 * s;
        const f32x4 a = *(const f32x4*)sp, b = *(const f32x4*)(sp + 4);
        u32x4 w; w.x = cvt_pk_bf16(a[0], a[1]); w.y = cvt_pk_bf16(a[2], a[3]); w.z = cvt_pk_bf16(b[0], b[1]); w.w = cvt_pk_bf16(b[2], b[3]);
        *(u32x4*)((bf16_t*)(ws + WS_SK) + (size_t)ch * 8) = w;
    }
    p0_convert(A.in[10], (bf16_t*)(ws + WS_WS), (size_t)8 * 128 * 128, nullptr, gw, NGW, lane);
    for (int rix0 = gw; rix0 < 4 * NEXP; rix0 += 4 * NGW) {
        f32x4 v[4][4]; bool upv[4]; int rv[4]; bool okv[4];
#pragma unroll
        for (int u = 0; u < 4; ++u) {
            const int rix = rix0 + u * NGW; okv[u] = rix < 4 * NEXP;
            const int rc = okv[u] ? rix : rix0;
            upv[u] = rc >= 2 * NEXP; rv[u] = upv[u] ? rc - 2 * NEXP : rc;
            const f32x4* sp = (const f32x4*)((upv[u] ? A.in[16] : A.in[15]) + (size_t)rv[u] * DM + 16 * lane);
#pragma unroll
            for (int j = 0; j < 4; ++j) v[u][j] = sp[j];
        }
        float am[4];
#pragma unroll
        for (int u = 0; u < 4; ++u) {
            if (!upv[u]) { const f32x4* gp = (const f32x4*)(norm_ffn + (rv[u] / NEXP) * DM + 16 * lane);
#pragma unroll
                for (int j = 0; j < 4; ++j) v[u][j] = v[u][j] * gp[j]; }
            float m = 0.f;
#pragma unroll
            for (int j = 0; j < 4; ++j) m = fmaxf(m, fmaxf(fmaxf(fabsf(v[u][j][0]), fabsf(v[u][j][1])), fmaxf(fabsf(v[u][j][2]), fabsf(v[u][j][3]))));
            am[u] = m;
        }
#pragma unroll
        for (int o = 1; o < 64; o <<= 1)
#pragma unroll
            for (int u = 0; u < 4; ++u) am[u] = fmaxf(am[u], __shfl_xor(am[u], o));
#pragma unroll
        for (int u = 0; u < 4; ++u) {
            if (!okv[u]) continue;
            const float amx = fmaxf(am[u], 1e-20f); const int r = rv[u];
            if (!upv[u]) {
                const float inv = 127.0f / amx;
                u32x4 w;
#pragma unroll
                for (int j = 0; j < 4; ++j) {
                    const int q0 = (int)rintf(v[u][j][0] * inv), q1 = (int)rintf(v[u][j][1] * inv), q2 = (int)rintf(v[u][j][2] * inv), q3 = (int)rintf(v[u][j][3] * inv);
                    w[j] = (unsigned)(q0 & 0xff) | ((unsigned)(q1 & 0xff) << 8) | ((unsigned)(q2 & 0xff) << 16) | ((unsigned)q3 << 24);
                }
                *(u32x4*)(ws + WS_WDQ + (size_t)r * DM + 16 * lane) = w;
                if (lane == 0) ((float*)(ws + WS_SDU))[2 * r] = amx * (1.0f / 127.0f);
            } else {
                const float inv = 6.0f / amx;
                u32x2 w4;
#pragma unroll
                for (int q = 0; q < 2; ++q) {
                    unsigned p = 0u;
                    p = __builtin_amdgcn_cvt_scalef32_pk_fp4_f32(p, v[u][2 * q][0] * inv, v[u][2 * q][1] * inv, 1.0f, 0);
                    p = __builtin_amdgcn_cvt_scalef32_pk_fp4_f32(p, v[u][2 * q][2] * inv, v[u][2 * q][3] * inv, 1.0f, 1);
                    p = __builtin_amdgcn_cvt_scalef32_pk_fp4_f32(p, v[u][2 * q + 1][0] * inv, v[u][2 * q + 1][1] * inv, 1.0f, 2);
                    p = __builtin_amdgcn_cvt_scalef32_pk_fp4_f32(p, v[u][2 * q + 1][2] * inv, v[u][2 * q + 1][3] * inv, 1.0f, 3);
                    w4[q] = p;
                }
                *(u32x2*)(ws + WS_WUQ + (size_t)r * (DM / 2) + 8 * lane) = w4;
                if (lane == 0) ((float*)(ws + WS_SDU))[2 * r + 1] = amx * (1.0f / 6.0f);
            }
        }
    }
    { float* tab = (float*)(ws + WS_TAB);
      for (int e = gw * 64 + lane; e < SEQ * 8; e += NGW * 64) {
          const int pos = e >> 3, i = e & 7;
          const float inv_freq = __builtin_amdgcn_exp2f(-(float)i * (18.931568569324174f / 8.0f));
          const float ang = (float)pos * inv_freq;
          const float kq = rintf(ang * 0.6366197723675814f);
          float r = fmaf(-kq, 1.5707963705062866f, ang); r = fmaf(-kq, -4.371138828673793e-08f, r);
          const float sr = __sinf(r), cr = __cosf(r);
          const int q = ((int)kq) & 3;
          const float s = (q == 0) ? sr : (q == 1) ? cr : (q == 2) ? -sr : -cr;
          const float c = (q == 0) ? cr : (q == 1) ? -sr : (q == 2) ? -cr : sr;
          tab[2 * e] = c; tab[2 * e + 1] = s;
      } }
    for (int m0 = gw; m0 < T; m0 += 4 * NGW) {
        f32x4 v[4][4]; float s[4];
#pragma unroll
        for (int u = 0; u < 4; ++u) { const int m = (m0 + u * NGW < T) ? m0 + u * NGW : m0; const f32x4* xr = (const f32x4*)(A.in[0] + (size_t)m * DM) + lane;
#pragma unroll
            for (int j = 0; j < 4; ++j) v[u][j] = xr[64 * j]; }
#pragma unroll
        for (int u = 0; u < 4; ++u) { float q = 0.f;
#pragma unroll
            for (int j = 0; j < 4; ++j) q += (v[u][j][0] * v[u][j][0] + v[u][j][1] * v[u][j][1]) + (v[u][j][2] * v[u][j][2] + v[u][j][3] * v[u][j][3]);
            s[u] = q; }
#pragma unroll
        for (int o = 1; o < 64; o <<= 1)
#pragma unroll
            for (int u = 0; u < 4; ++u) s[u] += __shfl_xor(s[u], o);
#pragma unroll
        for (int u = 0; u < 4; ++u) {
            const int m = m0 + u * NGW; if (m >= T) continue;
            const float rstd = __builtin_amdgcn_rsqf(s[u] * (1.0f / DM) + RMS_EPS);
            u32x2* o8 = (u32x2*)((bf16_t*)(ws + WS_XA) + (size_t)m * DM) + lane;
#pragma unroll
            for (int j = 0; j < 4; ++j) { u32x2 w; w.x = cvt_pk_bf16(v[u][j][0] * rstd, v[u][j][1] * rstd); w.y = cvt_pk_bf16(v[u][j][2] * rstd, v[u][j][3] * rstd); o8[64 * j] = w; }
        }
    }
}

__device__ __forceinline__ int crow(int r, int hi) { return (r & 3) + 8 * (r >> 2) + 4 * hi; }
__device__ __forceinline__ void attn_phase(const Args& A, LAS unsigned char* lds, int vcu, int G, int wave, int lane) {
    const bf16_t* PROJ = (const bf16_t*)(A.ws + WS_PROJ);
    bf16_t* OP = (bf16_t*)(A.ws + WS_OP);
    float* LSE = (float*)(A.ws + WS_LSE);
    LAS unsigned char* vbuf = lds + wave * 17408;
    LAS unsigned char* kbuf = vbuf + 8192;
    const int r32 = lane & 31, hh = lane >> 5, i16 = lane & 15;
    for (int bh = vcu; bh < BATCH * 8; bh += G) {
        const int b = bh >> 3, h = bh & 7;
        const bf16_t* base = PROJ + (size_t)b * SEQ * NPROJ + h * 64;
        for (int ti = wave; ti < 96; ti += NWAVES) {
            const int pat = ti >> 5, sub = ti & 31;
            int dil, res, lq0;
            if (pat == 0) { dil = 1; res = 0; lq0 = sub * 64; } else if (pat == 1) { dil = 4; res = sub >> 3; lq0 = (sub & 7) * 64; } else { dil = 16; res = sub >> 1; lq0 = (sub & 1) * 64; }
            const int L = SEQ / dil;
            bf16x8 Qf[2][4];
#pragma unroll
            for (int u = 0; u < 2; ++u) { const bf16_t* qp = base + (size_t)((lq0 + 32 * u + r32) * dil + res) * NPROJ + 32 * hh;
#pragma unroll
              for (int s = 0; s < 4; ++s) Qf[u][s] = *(const bf16x8*)(qp + 8 * s); }
            float m_run[2] = {-1e30f, -1e30f}, lsum[2] = {0.f, 0.f};
            f32x16 OT[2][2];
#pragma unroll
            for (int u = 0; u < 2; ++u)
#pragma unroll
                for (int i = 0; i < 16; ++i) { OT[u][0][i] = 0.f; OT[u][1][i] = 0.f; }
            int vb = 0;
#define BLK_J(jj) (((jj) < 2) ? (jj) + 2 : ((jj) < 4 ? (jj) - 2 : (jj)))
#define BLK_OK(jj) (!((lq0 - 64 + 32 * BLK_J(jj)) + 32 <= 0 || (lq0 - 64 + 32 * BLK_J(jj)) >= L))
#define BLK_LOAD(jj) do { const int lkb_ = lq0 - 64 + 32 * BLK_J(jj); _Pragma("unroll") for (int i = 0; i < 4; ++i) { const int lk = lkb_ + i * 8 + (lane >> 3); \
                const bf16_t* rp = base + (size_t)(lk * dil + res) * NPROJ + (lane & 7) * 8; kkN[i] = *(const u32x4*)(rp + 512); vvN[i] = *(const u32x4*)(rp + 1024); } } while (0)
            u32x4 kkN[4], vvN[4];
            BLK_LOAD(0);
#pragma unroll 1
            for (int jj = 0; jj < 6; ++jj) {
                if (!BLK_OK(jj)) continue;
                const int jblk = BLK_J(jj);
                const int lk0 = lq0 - 64 + 32 * jblk;
                LAS unsigned char* vl = vbuf + vb * 4096; LAS unsigned char* kl = kbuf + vb * 4608; vb ^= 1;
#pragma unroll
                for (int i = 0; i < 4; ++i) { *(LAS u32x4*)(kl + (i * 8 + (lane >> 3)) * 144 + (lane & 7) * 16) = kkN[i];
                    *(LAS u32x4*)(vl + (i * 8 + (lane >> 3)) * 128 + (lane & 7) * 16) = vvN[i]; }
                { int nj = jj + 1; while (nj < 6 && !BLK_OK(nj)) ++nj; if (nj < 6) BLK_LOAD(nj); }
                bf16x8 Kf[4];
#pragma unroll
                for (int s = 0; s < 4; ++s) Kf[s] = *(const LAS bf16x8*)(kl + r32 * 144 + 64 * hh + 16 * s);
                bf16x8 Vf[2][2];
#pragma unroll
                for (int db = 0; db < 2; ++db)
#pragma unroll
                    for (int s = 0; s < 2; ++s) {
                        const int R0 = 16 * s + 4 * hh, C0 = 32 * db + 16 * ((lane >> 4) & 1);
                        LAS unsigned char* a0 = vl + (R0 + (i16 >> 2)) * 128 + (C0 + 4 * (i16 & 3)) * 2;
                        const s16x4 t0 = __builtin_bit_cast(s16x4, __builtin_amdgcn_ds_read_tr16_b64_v4i16((LAS s16x4*)a0));
                        const s16x4 t1 = __builtin_bit_cast(s16x4, __builtin_amdgcn_ds_read_tr16_b64_v4i16((LAS s16x4*)(a0 + 8 * 128)));
                        Vf[db][s] = (bf16x8){t0[0], t0[1], t0[2], t0[3], t1[0], t1[1], t1[2], t1[3]};
                    }
#pragma unroll
                for (int u = 0; u < 2; ++u) {
                    const int jrel = jblk - u;
                    if (jrel < 0 || jrel > 4) continue;
                    const int lq = lq0 + 32 * u + r32;
                    f32x16 st;
#pragma unroll
                    for (int i = 0; i < 16; ++i) st[i] = 0.f;
#pragma unroll
                    for (int s = 0; s < 4; ++s) st = __builtin_amdgcn_mfma_f32_32x32x16_bf16(Kf[s], Qf[u][s], st, 0, 0, 0);
                    if (jrel == 0 || jrel == 4) {
#pragma unroll
                        for (int r = 0; r < 16; ++r) {
                            const int d = lk0 + crow(r, hh) - lq;
                            st[r] = (d <= 64 && d >= -64) ? st[r] : -1e30f;
                        }
                    }
                    float mb = fmaxf(st[0], st[1]);
#pragma unroll
                    for (int r = 2; r < 16; ++r) mb = fmaxf(mb, st[r]);
                    mb = fmaxf(mb, __shfl_xor(mb, 32));
                    if (__builtin_amdgcn_ballot_w64(mb > m_run[u] + 6.0f) != 0ull) {
                        const float m_new = fmaxf(m_run[u], mb);
                        const float alpha = __builtin_amdgcn_exp2f(m_run[u] - m_new);
                        m_run[u] = m_new;
                        lsum[u] *= alpha;
#pragma unroll
                        for (int i = 0; i < 16; ++i) { OT[u][0][i] *= alpha; OT[u][1][i] *= alpha; }
                    }
                    float ps = 0.f;
#pragma unroll
                    for (int r = 0; r < 16; ++r) { st[r] = __builtin_amdgcn_exp2f(st[r] - m_run[u]); ps += st[r]; }
                    lsum[u] += ps;
#pragma unroll
                    for (int s = 0; s < 2; ++s) {
                        u32x4 w; w.x = cvt_pk_bf16(st[8 * s + 0], st[8 * s + 1]); w.y = cvt_pk_bf16(st[8 * s + 2], st[8 * s + 3]);
                        w.z = cvt_pk_bf16(st[8 * s + 4], st[8 * s + 5]); w.w = cvt_pk_bf16(st[8 * s + 6], st[8 * s + 7]);
                        const bf16x8 Pf = __builtin_bit_cast(bf16x8, w);
                        OT[u][0] = __builtin_amdgcn_mfma_f32_32x32x16_bf16(Vf[0][s], Pf, OT[u][0], 0, 0, 0);
                        OT[u][1] = __builtin_amdgcn_mfma_f32_32x32x16_bf16(Vf[1][s], Pf, OT[u][1], 0, 0, 0);
                    }
                }
                asm volatile("" ::: "memory");
            }
#undef BLK_J
#undef BLK_OK
#undef BLK_LOAD
#pragma unroll
            for (int u = 0; u < 2; ++u) {
                const float lt = lsum[u] + __shfl_xor(lsum[u], 32);
                const float inv = __builtin_amdgcn_rcpf(lt);
                const size_t row = (size_t)b * SEQ + (size_t)((lq0 + 32 * u + r32) * dil + res);
                bf16_t* op = OP + ((size_t)pat * T + row) * 512 + h * 64;
#pragma unroll
                for (int g4 = 0; g4 < 4; ++g4) {
                    u32x2 w0, w1;
                    w0.x = cvt_pk_bf16(OT[u][0][4 * g4 + 0] * inv, OT[u][0][4 * g4 + 1] * inv); w0.y = cvt_pk_bf16(OT[u][0][4 * g4 + 2] * inv, OT[u][0][4 * g4 + 3] * inv);
                    w1.x = cvt_pk_bf16(OT[u][1][4 * g4 + 0] * inv, OT[u][1][4 * g4 + 1] * inv); w1.y = cvt_pk_bf16(OT[u][1][4 * g4 + 2] * inv, OT[u][1][4 * g4 + 3] * inv);
                    *(u32x2*)(op + 8 * g4 + 4 * hh) = w0;
                    *(u32x2*)(op + 32 + 8 * g4 + 4 * hh) = w1;
                }
                if (hh == 0) LSE[((size_t)pat * T + row) * 8 + h] = m_run[u] + __builtin_amdgcn_logf(lt);
            }
        }
    }
}

template <int WIN>
__device__ __forceinline__ void pool_task(const bf16_t* PROJ, const bf16_t* WP, bf16_t* MIX, int g, int t0, int lane) {
    const int fr = lane & 15, fq = lane >> 4;
    constexpr int HW = WIN / 2;
    f32x4 acc[2][8];
#pragma unroll
    for (int m = 0; m < 2; ++m)
#pragma unroll
        for (int n = 0; n < 8; ++n) acc[m][n] = (f32x4){0.f, 0.f, 0.f, 0.f};
#pragma unroll 1
    for (int s = 0; s < 4; ++s) {
        bf16x8 Af[2];
        const bf16_t* colp = PROJ + 1536 + g * 128 + 32 * s + 8 * fq;
#pragma unroll
        for (int m = 0; m < 2; ++m) {
            const int t = t0 + m * 16 + fr, pos = t & (SEQ - 1);
            float sum[8];
#pragma unroll
            for (int k = 0; k < 8; ++k) sum[k] = 0.f;
            int cnt = 0;
            u32x4 self;
            constexpr int CH = WIN < 8 ? WIN : 8;
#pragma unroll
            for (int j0 = 0; j0 < WIN; j0 += CH) {
                u32x4 v[CH];
#pragma unroll
                for (int j = 0; j < CH; ++j) {
                    const int p = pos - HW + j0 + j;
                    const int pc = (p >= 0 && p < SEQ) ? p : pos;
                    v[j] = *(const u32x4*)(colp + (size_t)(t - pos + pc) * NPROJ);
                }
#pragma unroll
                for (int j = 0; j < CH; ++j) {
                    const int p = pos - HW + j0 + j;
                    const bool ok = (p >= 0) && (p < SEQ);
                    const float f = ok ? 1.f : 0.f; cnt += ok ? 1 : 0;
                    if (j0 + j == HW) self = v[j];
#pragma unroll
                    for (int k = 0; k < 4; ++k) { sum[2 * k] += f * bf_lo(v[j][k]); sum[2 * k + 1] += f * bf_hi(v[j][k]); }
                }
                if (WIN >= 16) asm volatile("" ::: "memory");
            }
            const float ic = 1.0f / (float)cnt;
            u32x4 w;
#pragma unroll
            for (int k = 0; k < 4; ++k) w[k] = cvt_pk_bf16(sum[2 * k] * ic - bf_lo(self[k]), sum[2 * k + 1] * ic - bf_hi(self[k]));
            Af[m] = __builtin_bit_cast(bf16x8, w);
        }
#pragma unroll
        for (int n = 0; n < 8; ++n) {
            const bf16x8 Wf = *(const bf16x8*)(WP + (size_t)g * 128 * 128 + (size_t)(n * 16 + fr) * 128 + 32 * s + 8 * fq);
#pragma unroll
            for (int m = 0; m < 2; ++m) acc[m][n] = __builtin_amdgcn_mfma_f32_16x16x32_bf16(Wf, Af[m], acc[m][n], 0, 0, 0);
        }
    }
#pragma unroll
    for (int m = 0; m < 2; ++m) {
        bf16_t* rowp = MIX + (size_t)(t0 + m * 16 + fr) * DM + 512 + g * 128 + 4 * fq;
#pragma unroll
        for (int n = 0; n < 8; ++n) { u32x2 w; w.x = cvt_pk_bf16(acc[m][n][0], acc[m][n][1]); w.y = cvt_pk_bf16(acc[m][n][2], acc[m][n][3]); *(u32x2*)(rowp + n * 16) = w; }
    }
}
__device__ __forceinline__ void mixab_phase(const Args& A, int vcu, int G, int wave, int lane) {
    const bf16_t* PROJ = (const bf16_t*)(A.ws + WS_PROJ);
    const bf16_t* OP = (const bf16_t*)(A.ws + WS_OP);
    const float* LSE = (const float*)(A.ws + WS_LSE);
    const bf16_t* WP = (const bf16_t*)(A.ws + WS_WPOOL);
    bf16_t* MIX = (bf16_t*)(A.ws + WS_MIX);
    const int gw = vcu * NWAVES + wave, NGW = G * NWAVES;
    for (int it0 = gw * 4; it0 < T; it0 += NGW * 4) {
        float l0[4], l1[4], l2[4]; u32x4 a[4], bq[4], c[4];
#pragma unroll
        for (int u = 0; u < 4; ++u) {
            const int th = (it0 + u) * 8 + (lane >> 3);
            const int t = th >> 3, h = th & 7, ch = lane & 7;
            l0[u] = LSE[((size_t)0 * T + t) * 8 + h]; l1[u] = LSE[((size_t)1 * T + t) * 8 + h]; l2[u] = LSE[((size_t)2 * T + t) * 8 + h];
            const size_t o = (size_t)t * 512 + h * 64 + ch * 8;
            a[u] = *(const u32x4*)(OP + o); bq[u] = *(const u32x4*)(OP + (size_t)T * 512 + o); c[u] = *(const u32x4*)(OP + (size_t)2 * T * 512 + o);
        }
#pragma unroll
        for (int u = 0; u < 4; ++u) {
            const int th = (it0 + u) * 8 + (lane >> 3);
            const int t = th >> 3, h = th & 7, ch = lane & 7;
            const float mx = fmaxf(l0[u], fmaxf(l1[u], l2[u]));
            float w0 = __builtin_amdgcn_exp2f(l0[u] - mx), w1 = __builtin_amdgcn_exp2f(l1[u] - mx), w2 = __builtin_amdgcn_exp2f(l2[u] - mx);
            const float inv = __builtin_amdgcn_rcpf(w0 + w1 + w2); w0 *= inv; w1 *= inv; w2 *= inv;
            u32x4 r;
#pragma unroll
            for (int k = 0; k < 4; ++k) {
                const float lo = w0 * bf_lo(a[u][k]) + w1 * bf_lo(bq[u][k]) + w2 * bf_lo(c[u][k]);
                const float hi = w0 * bf_hi(a[u][k]) + w1 * bf_hi(bq[u][k]) + w2 * bf_hi(c[u][k]);
                r[k] = cvt_pk_bf16(lo, hi);
            }
            *(u32x4*)(MIX + (size_t)t * DM + h * 64 + ch * 8) = r;
        }
    }
    for (int it = gw; it < (T / 32) * 4; it += NGW) {
        const int g = it & 3, t0 = (it >> 2) * 32;
        if (g == 0) pool_task<2>(PROJ, WP, MIX, 0, t0, lane);
        else if (g == 1) pool_task<4>(PROJ, WP, MIX, 1, t0, lane);
        else if (g == 2) pool_task<8>(PROJ, WP, MIX, 2, t0, lane);
        else pool_task<16>(PROJ, WP, MIX, 3, t0, lane);
    }
}

#define CE_DESC(x, a, b) do { const float _hi = fmaxf(x[a], x[b]); x[b] = fminf(x[a], x[b]); x[a] = _hi; } while (0)
#define CE_ASC(x, a, b)  do { const float _lo = fminf(x[a], x[b]); x[b] = fmaxf(x[a], x[b]); x[a] = _lo; } while (0)
__device__ __forceinline__ void bitonic_merge16_desc(float (&x)[16]) {
#pragma unroll
    for (int j = 8; j >= 1; j >>= 1)
#pragma unroll
        for (int i = 0; i < 16; ++i) { const int l = i ^ j; if (l > i) CE_DESC(x, i, l); }
}
__device__ __forceinline__ void bitonic_sort16_desc(float (&x)[16]) {
    CE_DESC(x,0,1);CE_DESC(x,2,3);CE_DESC(x,0,2);CE_DESC(x,1,3);CE_DESC(x,1,2);CE_DESC(x,4,5);CE_DESC(x,6,7);CE_DESC(x,4,6);CE_DESC(x,5,7);CE_DESC(x,5,6);CE_DESC(x,0,4);CE_DESC(x,2,6);CE_DESC(x,2,4);CE_DESC(x,1,5);CE_DESC(x,3,7);CE_DESC(x,3,5);
    CE_DESC(x,1,2);CE_DESC(x,3,4);CE_DESC(x,5,6);CE_DESC(x,8,9);CE_DESC(x,10,11);CE_DESC(x,8,10);CE_DESC(x,9,11);CE_DESC(x,9,10);CE_DESC(x,12,13);CE_DESC(x,14,15);CE_DESC(x,12,14);CE_DESC(x,13,15);CE_DESC(x,13,14);CE_DESC(x,8,12);CE_DESC(x,10,14);CE_DESC(x,10,12);
    CE_DESC(x,9,13);CE_DESC(x,11,15);CE_DESC(x,11,13);CE_DESC(x,9,10);CE_DESC(x,11,12);CE_DESC(x,13,14);CE_DESC(x,0,8);CE_DESC(x,4,12);CE_DESC(x,4,8);CE_DESC(x,2,10);CE_DESC(x,6,14);CE_DESC(x,6,10);CE_DESC(x,2,4);CE_DESC(x,6,8);CE_DESC(x,10,12);CE_DESC(x,1,9);
    CE_DESC(x,5,13);CE_DESC(x,5,9);CE_DESC(x,3,11);CE_DESC(x,7,15);CE_DESC(x,7,11);CE_DESC(x,3,5);CE_DESC(x,7,9);CE_DESC(x,11,13);CE_DESC(x,1,2);CE_DESC(x,3,4);CE_DESC(x,5,6);CE_DESC(x,7,8);CE_DESC(x,9,10);CE_DESC(x,11,12);CE_DESC(x,13,14);
}
__device__ __forceinline__ void merge_top16(float (&L)[16], const float (&S)[16]) {
#pragma unroll
    for (int j = 0; j < 16; ++j) L[j] = fmaxf(L[j], S[15 - j]);
    bitonic_merge16_desc(L);
}
__device__ __forceinline__ void quant_rows(const struct Args& A, int row0, int lane);
#define INS16(L, v) do { float _v = (v); _Pragma("unroll") for (int _j = 0; _j < 16; ++_j) { const float _t = fmaxf(L[_j], _v); _v = fminf(L[_j], _v); L[_j] = _t; } } while (0)
__device__ __forceinline__ void topk_phase(const Args& A, LAS unsigned char* lds, int layer, int vcu, int G, int wave, int lane) {
    const bf16_t* Q2 = (const bf16_t*)(A.ws + WS_PROJ);
    const bf16_t* SK = (const bf16_t*)(A.ws + WS_SK) + (size_t)layer * 8 * 2 * 128 * 128;
    int* EXP = (int*)(A.ws + WS_EXP);
    float* GATE = (float*)(A.ws + WS_GATE);
    LAS unsigned* lidx = (LAS unsigned*)(lds + 65536 + wave * 8192);
    const int r32 = lane & 31, hh = lane >> 5, tid = threadIdx.x;
    for (int grp = vcu; grp < T / 256; grp += G) {
      const int tb = grp * 8 + wave;
#pragma unroll 1
      for (int i = 0; i < 8; ++i) quant_rows(A, tb * 32 + 4 * i, lane);
      bf16x8 QfN[8];
      { const bf16_t* qp = Q2 + ((((size_t)tb * 8 + 0) * 2 + 0) * 8 * 64 + lane) * 8;
#pragma unroll
        for (int s = 0; s < 8; ++s) QfN[s] = *(const bf16x8*)(qp + (size_t)s * 64 * 8); }
      u32x4 skn[8];
      { const u32x4* sp = (const u32x4*)SK + tid;
#pragma unroll
        for (int k = 0; k < 8; ++k) skn[k] = sp[k * 512]; }
#pragma unroll 1
      for (int h = 0; h < 8; ++h) {
        __syncthreads();
#pragma unroll
        for (int k = 0; k < 8; ++k) *(LAS u32x4*)(lds + (size_t)(tid + k * 512) * 16) = skn[k];
        if (h + 1 < 8) { const u32x4* sp = (const u32x4*)(SK + (size_t)(h + 1) * 2 * 128 * 128) + tid;
#pragma unroll
            for (int k = 0; k < 8; ++k) skn[k] = sp[k * 512]; }
        __syncthreads();
        const int t = tb * 32 + r32;
        float La[16], Lb[16];
#pragma unroll
        for (int half = 0; half < 2; ++half) {
            bf16x8 Qf[8];
            if (half == 0) {
#pragma unroll
                for (int s = 0; s < 8; ++s) Qf[s] = QfN[s];
                if (h + 1 < 8) { const bf16_t* qn = Q2 + ((((size_t)tb * 8 + h + 1) * 2 + 0) * 8 * 64 + lane) * 8;
#pragma unroll
                    for (int s = 0; s < 8; ++s) QfN[s] = *(const bf16x8*)(qn + (size_t)s * 64 * 8); }
            } else { const bf16_t* qp = Q2 + ((((size_t)tb * 8 + h) * 2 + half) * 8 * 64 + lane) * 8;
#pragma unroll
              for (int s = 0; s < 8; ++s) Qf[s] = *(const bf16x8*)(qp + (size_t)s * 64 * 8); }
            float Ls[16];
#pragma unroll
            for (int j = 0; j < 16; ++j) Ls[j] = -3.0e38f;
            const LAS unsigned char* skb = lds + (size_t)half * 32768 + lane * 16;
#pragma unroll 1
            for (int kb = 0; kb < 4; ++kb) {
                f32x16 st;
#pragma unroll
                for (int i = 0; i < 16; ++i) st[i] = 0.f;
                const LAS unsigned char* kp = skb + kb * 8192;
#pragma unroll
                for (int s = 0; s < 8; ++s) { const bf16x8 Kf = *(const LAS bf16x8*)(kp + s * 1024); st = __builtin_amdgcn_mfma_f32_32x32x16_bf16(Kf, Qf[s], st, 0, 0, 0); }
                float Sb[16];
#pragma unroll
                for (int r = 0; r < 16; ++r) {
                    const unsigned idx = (unsigned)(kb * 32 + crow(r, hh));
                    Sb[r] = __uint_as_float((__float_as_uint(st[r]) & 0xffffff80u) | idx);
                }
                bitonic_sort16_desc(Sb);
                merge_top16(Ls, Sb);
            }
            float Po[16];
#pragma unroll
            for (int j = 0; j < 16; ++j) Po[j] = __shfl_xor(Ls[j], 32);
            merge_top16(Ls, Po);
#pragma unroll
            for (int j = 0; j < 16; ++j) { if (half == 0) La[j] = Ls[j]; else Lb[j] = Ls[j]; }
        }
#pragma unroll
        for (int j = 0; j < 16; ++j) { lidx[j * 64 + lane] = __float_as_uint(La[j]) & 0x7fu; lidx[(16 + j) * 64 + lane] = __float_as_uint(Lb[j]) & 0x7fu; }
#define CAND(i, j) __uint_as_float((__float_as_uint(La[i] + Lb[j]) & 0xffffff00u) | (unsigned)((i) * 16 + (j)))
        float Lc[16], M1[16], Y[16];
#pragma unroll
        for (int j = 0; j < 16; ++j) Lc[j] = CAND(0, j);
#pragma unroll
        for (int j = 0; j < 8; ++j) { M1[j] = CAND(1, j); M1[15 - j] = CAND(8 + j, 0); }
        bitonic_merge16_desc(M1);
        Y[0] = CAND(2, 0); Y[1] = CAND(2, 1); Y[2] = CAND(2, 2); Y[3] = CAND(2, 3); Y[4] = CAND(2, 4);
        Y[5] = CAND(3, 0); Y[6] = CAND(3, 1); Y[7] = CAND(3, 2); Y[8] = CAND(3, 3);
        Y[9] = CAND(4, 0); Y[10] = CAND(4, 1); Y[11] = CAND(4, 2);
        Y[12] = CAND(5, 0); Y[13] = CAND(5, 1); Y[14] = CAND(6, 0); Y[15] = CAND(6, 1);
        bitonic_sort16_desc(Y);
        merge_top16(Lc, M1);
        merge_top16(Lc, Y);
        { const float c70 = CAND(7, 0), c71 = CAND(7, 1); INS16(Lc, c70); INS16(Lc, c71); }
#undef CAND
        float e[16]; float es = 0.f;
#pragma unroll
        for (int j = 0; j < 16; ++j) { e[j] = __builtin_amdgcn_exp2f((Lc[j] - Lc[0]) * LOG2E); es += e[j]; }
        const float inv = __builtin_amdgcn_rcpf(es);
        asm volatile("s_waitcnt lgkmcnt(0)" ::: "memory");
#pragma unroll
        for (int j = 0; j < 16; ++j) {
            const unsigned ci = __float_as_uint(Lc[j]) & 0xffu;
            const unsigned i1 = lidx[(ci >> 4) * 64 + lane], i2 = lidx[(16 + (ci & 15)) * 64 + lane];
            if ((j >> 3) == hh) {
                EXP[(size_t)t * 128 + h * 16 + j] = (int)(i1 * 128 + i2);
                GATE[(size_t)t * 128 + h * 16 + j] = e[j] * inv;
            }
        }
        asm volatile("s_waitcnt lgkmcnt(0)" ::: "memory");
      }
    }
}

#define XB_TMO      128
#define XB_XCNT(j)  (256  + 64 * (j))
#define XB_XSUB(j)  (1280 + 64 * (j))
#define XB_XGEN(j)  (2304 + 64 * (j))
#define XB_TOP      3328
#define XB_TOPGEN   3392
#define XCD_BAR_WORDS 3456
#define XB_SPIN_CAP (1u << 20)
__device__ __forceinline__ unsigned xb_ld(unsigned* p)              { return __hip_atomic_load(p, __ATOMIC_RELAXED, __HIP_MEMORY_SCOPE_AGENT); }
__device__ __forceinline__ unsigned xb_add(unsigned* p, unsigned v) { return __hip_atomic_fetch_add(p, v, __ATOMIC_RELAXED, __HIP_MEMORY_SCOPE_AGENT); }
__device__ __forceinline__ unsigned xb_xcc_id() { return (unsigned)__builtin_amdgcn_s_getreg((3 << 11) | 20) & 0xFu; }
#define XB_SPIN(cond, bar) do { unsigned _sp = 0; while (cond) { __builtin_amdgcn_s_sleep(1); \
    if ((++_sp & 255u) == 0u) { if (xb_ld(&(bar)[XB_TMO])) break; if (_sp > XB_SPIN_CAP) { atomicAdd(&(bar)[XB_TMO], 1u); break; } } } } while (0)
struct XcdBarrier { unsigned* bar; unsigned x; volatile LAS unsigned* st; };
__device__ __forceinline__ XcdBarrier xcd_barrier_post(unsigned* bar, volatile LAS unsigned* st) {
    XcdBarrier b; b.bar = bar; b.x = xb_xcc_id(); b.st = st;
    if (threadIdx.x == 0) (void)xb_add(&bar[XB_XCNT(b.x)], 1u);
    return b;
}
__device__ __forceinline__ void xcd_barrier_complete(unsigned* bar, unsigned x, unsigned& nloc, unsigned& nx) {
    const unsigned G = gridDim.x * gridDim.y * gridDim.z;
    unsigned sum, cnt, mine, sp = 0u;
    for (;;) {
        sum = 0u; cnt = 0u; mine = 0u;
#pragma unroll
        for (unsigned j = 0; j < 16; ++j) { const unsigned c = xb_ld(&bar[XB_XCNT(j)]); sum += c; cnt += (c > 0u) ? 1u : 0u; mine = (j == x) ? c : mine; }
        if (sum == G) break;
        __builtin_amdgcn_s_sleep(1);
        if ((++sp & 255u) == 0u) { if (xb_ld(&bar[XB_TMO])) break; if (sp > XB_SPIN_CAP) { atomicAdd(&bar[XB_TMO], 1u); break; } }
    }
    nloc = mine > 0u ? mine : 1u; nx = cnt > 0u ? cnt : 1u;
}
__device__ __forceinline__ void xcd_barrier(const XcdBarrier& b) {
    asm volatile("s_waitcnt vmcnt(0)" ::: "memory");
    __syncthreads();
    if (threadIdx.x == 0) {
        unsigned* bar = b.bar;
        __builtin_amdgcn_s_waitcnt(0);
        unsigned nloc = b.st[0], nx = b.st[1];
        if (nloc == 0u) { xcd_barrier_complete(bar, b.x, nloc, nx); b.st[0] = nloc; b.st[1] = nx; }
        const unsigned old = xb_add(&bar[XB_XSUB(b.x)], 1u);
        const unsigned gen = old / nloc;
        if (old + 1u == (gen + 1u) * nloc) {
            __builtin_amdgcn_fence(__ATOMIC_RELEASE, "agent");
            asm volatile("s_waitcnt vmcnt(0)" ::: "memory");
            const unsigned og = xb_add(&bar[XB_TOP], 1u);
            const unsigned tg = og / nx;
            if (og + 1u == (tg + 1u) * nx) xb_add(&bar[XB_TOPGEN], 1u);
            else XB_SPIN(xb_ld(&bar[XB_TOPGEN]) == tg, bar);
            __builtin_amdgcn_fence(__ATOMIC_ACQUIRE, "agent");
            xb_add(&bar[XB_XGEN(b.x)], 1u);
            asm volatile("s_waitcnt vmcnt(0)" ::: "memory");
        } else {
            XB_SPIN(xb_ld(&bar[XB_XGEN(b.x)]) == gen, bar);
            __builtin_amdgcn_fence(__ATOMIC_ACQUIRE, "agent");
            asm volatile("s_waitcnt vmcnt(0)" ::: "memory");
        }
    }
    __syncthreads();
}


__device__ __forceinline__ int dpp_sum_i32(int v) {
    v += __builtin_amdgcn_update_dpp(0, v, 0x111, 0xf, 0xf, true);
    v += __builtin_amdgcn_update_dpp(0, v, 0x112, 0xf, 0xf, true);
    v += __builtin_amdgcn_update_dpp(0, v, 0x114, 0xf, 0xf, true);
    v += __builtin_amdgcn_update_dpp(0, v, 0x118, 0xf, 0xf, true);
    v += __builtin_amdgcn_update_dpp(0, v, 0x142, 0xa, 0xf, false);
    v += __builtin_amdgcn_update_dpp(0, v, 0x143, 0xc, 0xf, false);
    return v;
}
__device__ __forceinline__ void quant_rows(const Args& A, int row0, int lane) {
    const bf16_t* XB = (const bf16_t*)(A.ws + WS_XA);
    const float* SQ = (const float*)(A.ws + WS_SQ);
    u32x4 a[4], b[4]; f32x4 s[4][4];
#pragma unroll
    for (int i = 0; i < 4; ++i) {
        const int t = row0 + i;
        a[i] = *(const u32x4*)(XB + (size_t)t * DM + 16 * lane); b[i] = *(const u32x4*)(XB + (size_t)t * DM + 16 * lane + 8);
        const f32x4* sp = (const f32x4*)(SQ + (size_t)t * 16);
        s[i][0] = sp[0]; s[i][1] = sp[1]; s[i][2] = sp[2]; s[i][3] = sp[3];
    }
    float am[4]; float h[4][16];
#pragma unroll
    for (int i = 0; i < 4; ++i) {
        const float ssum = ((s[i][0][0] + s[i][0][1]) + (s[i][0][2] + s[i][0][3])) + ((s[i][1][0] + s[i][1][1]) + (s[i][1][2] + s[i][1][3]))
                         + ((s[i][2][0] + s[i][2][1]) + (s[i][2][2] + s[i][2][3])) + ((s[i][3][0] + s[i][3][1]) + (s[i][3][2] + s[i][3][3]));
        const float rstd = __builtin_amdgcn_rsqf(ssum * (1.0f / DM) + RMS_EPS);
        float m = 0.f;
#pragma unroll
        for (int k = 0; k < 4; ++k) { h[i][2 * k] = bf_lo(a[i][k]) * rstd; h[i][2 * k + 1] = bf_hi(a[i][k]) * rstd; h[i][8 + 2 * k] = bf_lo(b[i][k]) * rstd; h[i][8 + 2 * k + 1] = bf_hi(b[i][k]) * rstd; }
#pragma unroll
        for (int k = 0; k < 16; ++k) m = fmaxf(m, fabsf(h[i][k]));
        am[i] = m;
    }
#pragma unroll
    for (int o = 1; o < 64; o <<= 1)
#pragma unroll
        for (int i = 0; i < 4; ++i) am[i] = fmaxf(am[i], __shfl_xor(am[i], o));
#pragma unroll
    for (int i = 0; i < 4; ++i) {
        const int t = row0 + i;
        const float amx = fmaxf(am[i], 1e-20f);
        const float inv = 127.0f / amx;
        u32x4 w;
#pragma unroll
        for (int j = 0; j < 4; ++j) {
            const int q0 = (int)rintf(h[i][4 * j] * inv), q1 = (int)rintf(h[i][4 * j + 1] * inv), q2 = (int)rintf(h[i][4 * j + 2] * inv), q3 = (int)rintf(h[i][4 * j + 3] * inv);
            w[j] = (unsigned)(q0 & 0xff) | ((unsigned)(q1 & 0xff) << 8) | ((unsigned)(q2 & 0xff) << 16) | ((unsigned)q3 << 24);
        }
        *(u32x4*)(A.ws + WS_XQ + (size_t)t * DM + 16 * lane) = w;
        if (lane == 0) ((float*)(A.ws + WS_XS))[t] = amx * (1.0f / 127.0f);
    }
}

constexpr int DOWN_TB = 512;
constexpr int DSTEP = 4;
typedef int i32x4 __attribute__((ext_vector_type(4)));
__device__ __forceinline__ int row_scan_add(int v) {
    v += __builtin_amdgcn_update_dpp(0, v, 0x111, 0xf, 0xf, true);
    v += __builtin_amdgcn_update_dpp(0, v, 0x112, 0xf, 0xf, true);
    v += __builtin_amdgcn_update_dpp(0, v, 0x114, 0xf, 0xf, true);
    v += __builtin_amdgcn_update_dpp(0, v, 0x118, 0xf, 0xf, true);
    return v;
}
__device__ __forceinline__ void expert_down_phase(const Args& A, LAS unsigned char* lds, int layer, int G, int bx, int wave, int lane, int mode = 0) {
    const unsigned char* WDQ = A.ws + WS_WDQ + (size_t)layer * NEXP * DM;
    const f32x2* SDU = (const f32x2*)(A.ws + WS_SDU) + layer * NEXP;
    const float* XS = (const float*)(A.ws + WS_XS);
    const int* EXP = (const int*)(A.ws + WS_EXP);
    const float* GATE = (const float*)(A.ws + WS_GATE);
    float* GOUT = mode ? (float*)(A.ws + WS_OP) : (float*)(A.ws + WS_GATE);
    const int emask = (mode == 2) ? 0x3f : 0x3fff;
    const int g = lane >> 4, i = lane & 15;
    LAS int* llist = (LAS int*)(lds + 16384 + wave * 6144) + g * 128;
    LAS float* lgate = (LAS float*)(llist + 512);
    LAS int* lres = llist + 1024;
    volatile LAS int* lq = (volatile LAS int*)(lds + 8192);
    unsigned* qh = (unsigned*)(A.ws + WS_CTL) + 8192 + (layer + (mode ? 2 : 0)) * 8 * 64;
    const int myx = (int)(xb_xcc_id() & 7u);
    constexpr int NITEM = T / DOWN_TB;
    for (int rr = 0; rr < 8; ++rr) {
        const int range = (myx + rr) & 7;
        for (;;) {
            __syncthreads();
            if (threadIdx.x == 0) lq[0] = (int)__hip_atomic_fetch_add(qh + range * 64, 1u, __ATOMIC_RELAXED, __HIP_MEMORY_SCOPE_AGENT);
            __syncthreads();
            const int item = lq[0];
            if (item >= NITEM) break;
            struct Hdr { u32x4 xq[4]; i32x4 ea, eb; f32x4 ga, gb; float st; };
#define HDR_LOAD(H, tt) do { _Pragma("unroll") for (int c = 0; c < 4; ++c) H.xq[c] = *(const u32x4*)(A.ws + WS_XQ + (size_t)(tt) * DM + 16 * i + 256 * c); \
                H.ea = *(const i32x4*)(EXP + (size_t)(tt) * 128 + 8 * i); H.eb = *(const i32x4*)(EXP + (size_t)(tt) * 128 + 8 * i + 4); \
                H.ga = *(const f32x4*)(GATE + (size_t)(tt) * 128 + 8 * i); H.gb = *(const f32x4*)(GATE + (size_t)(tt) * 128 + 8 * i + 4); H.st = XS[tt]; } while (0)
            const int tw = item * DOWN_TB + wave * (DOWN_TB / NWAVES) + g;
            constexpr int NIT = DOWN_TB / (NWAVES * 4);
            Hdr hn; HDR_LOAD(hn, tw);
#pragma unroll 1
            for (int it = 0; it < NIT; ++it) {
                const int t = tw + it * 4;
                const Hdr h = hn;
                int cnt = 0;
#pragma unroll
                for (int k = 0; k < 4; ++k) { cnt += ((h.ea[k] >> 11) == range) ? 1 : 0; cnt += ((h.eb[k] >> 11) == range) ? 1 : 0; }
                const int incl = row_scan_add(cnt);
                int pos = incl - cnt;
                const int n0 = __builtin_amdgcn_readlane(incl, 15), n1 = __builtin_amdgcn_readlane(incl, 31), n2 = __builtin_amdgcn_readlane(incl, 47), n3 = __builtin_amdgcn_readlane(incl, 63);
                const int ng = (g == 0) ? n0 : (g == 1) ? n1 : (g == 2) ? n2 : n3;
                int nmax = n0 > n1 ? n0 : n1; nmax = nmax > n2 ? nmax : n2; nmax = nmax > n3 ? nmax : n3;
#pragma unroll
                for (int k = 0; k < 8; ++k) {
                    const int e = (k < 4) ? h.ea[k & 3] : h.eb[k & 3]; const float gt = (k < 4) ? h.ga[k & 3] : h.gb[k & 3];
                    if ((e >> 11) == range) { llist[pos] = ((e & emask) << 8) | (8 * i + k); lgate[pos] = gt; ++pos; }
                }
                f32x2 sc0 = {0.f, 0.f}, sc1 = {0.f, 0.f};
                if (i < ng) sc0 = SDU[llist[i] >> 8];
                if (i + 16 < ng) sc1 = SDU[llist[i + 16] >> 8];
                bool pref = (it + 1 >= NIT) || mode == 6;
#pragma unroll 1
                for (int s0 = 0; s0 < nmax; s0 += DSTEP) {
                    u32x4 w[DSTEP][4];
#pragma unroll
                    for (int u = 0; u < DSTEP; ++u) {
                        if (s0 + u < ng) {
                            const unsigned char* rp = WDQ + (size_t)(llist[s0 + u] >> 8) * DM + 16 * i;
#pragma unroll
                            for (int c = 0; c < 4; ++c) w[u][c] = *(const u32x4*)(rp + 256 * c);
                        }
                    }
                    if (!pref) { pref = true; HDR_LOAD(hn, t + 4); }
                    int p[DSTEP];
#pragma unroll
                    for (int u = 0; u < DSTEP; ++u) {
                        int a0 = 0, a1 = 0, a2 = 0, a3 = 0;
#pragma unroll
                        for (int d = 0; d < 4; ++d) {
                            a0 = __builtin_amdgcn_sdot4((int)w[u][0][d], (int)h.xq[0][d], a0, false); a1 = __builtin_amdgcn_sdot4((int)w[u][1][d], (int)h.xq[1][d], a1, false);
                            a2 = __builtin_amdgcn_sdot4((int)w[u][2][d], (int)h.xq[2][d], a2, false); a3 = __builtin_amdgcn_sdot4((int)w[u][3][d], (int)h.xq[3][d], a3, false);
                        }
                        p[u] = (a0 + a1) + (a2 + a3);
                    }
#pragma unroll
                    for (int u = 0; u < DSTEP; ++u) p[u] += __builtin_amdgcn_update_dpp(0, p[u], 0x111, 0xf, 0xf, true);
#pragma unroll
                    for (int u = 0; u < DSTEP; ++u) p[u] += __builtin_amdgcn_update_dpp(0, p[u], 0x112, 0xf, 0xf, true);
#pragma unroll
                    for (int u = 0; u < DSTEP; ++u) p[u] += __builtin_amdgcn_update_dpp(0, p[u], 0x114, 0xf, 0xf, true);
#pragma unroll
                    for (int u = 0; u < DSTEP; ++u) p[u] += __builtin_amdgcn_update_dpp(0, p[u], 0x118, 0xf, 0xf, true);
#pragma unroll
                    for (int u = 0; u < DSTEP; ++u) if (i == 15 && s0 + u < ng) lres[s0 + u] = p[u];
                }
                if (!pref) HDR_LOAD(hn, t + 4);
                if (i < ng) { const int ent = llist[i]; GOUT[(size_t)t * 128 + (ent & 0xff)] = lgate[i] * gelu_tanh((float)lres[i] * h.st * sc0[0]) * sc0[1]; }
                if (i + 16 < ng) { const int ent = llist[i + 16]; GOUT[(size_t)t * 128 + (ent & 0xff)] = lgate[i + 16] * gelu_tanh((float)lres[i + 16] * h.st * sc1[0]) * sc1[1]; }
#pragma unroll 1
                for (int k = i + 32; k < nmax; k += 16) {
                    if (k < ng) {
                        const int ent = llist[k]; const f32x2 sc = SDU[ent >> 8];
                        GOUT[(size_t)t * 128 + (ent & 0xff)] = lgate[k] * gelu_tanh((float)lres[k] * h.st * sc[0]) * sc[1];
                    }
                }
            }
#undef HDR_LOAD
        }
    }
}

constexpr int UP_NT = 4;
__device__ __forceinline__ void expert_up_phase(const Args& A, LAS unsigned char* lds, int layer, int vcu, int G, int wave, int lane, bool dry = false, unsigned nloc = 0u) {
    const unsigned char* WUQ = A.ws + WS_WUQ + (size_t)layer * NEXP * (DM / 2);
    const int* EXP = (const int*)(A.ws + WS_EXP);
    const float* COEF = (const float*)(A.ws + WS_GATE);
    const bf16_t* X = (const bf16_t*)(A.ws + WS_XA);
    bf16_t* XO = (bf16_t*)(A.ws + (dry ? WS_PROJ : WS_XA));
    bf16_t* XN = (bf16_t*)(A.ws + (dry ? WS_PROJ + 128 * MiB : WS_OP));
    float* FO = dry ? (float*)(A.ws + WS_PROJ) : A.out;
    const float* gfin = A.in[3];
    const int gw = vcu * NWAVES + wave, NGW = G * NWAVES;
    int swi = 0;
    for (int t0 = gw * UP_NT; t0 < T; t0 += NGW * UP_NT, ++swi) {
        int e_lo[UP_NT], e_hi[UP_NT]; float c_lo[UP_NT], c_hi[UP_NT];
#pragma unroll
        for (int b = 0; b < UP_NT; ++b) { const size_t o = (size_t)(t0 + b) * 128; e_lo[b] = EXP[o + lane]; e_hi[b] = EXP[o + 64 + lane]; c_lo[b] = COEF[o + lane]; c_hi[b] = COEF[o + 64 + lane]; }
#pragma unroll
        for (int b = 0; b < UP_NT; ++b) {
            LAS int* se = (LAS int*)(lds + 16384 + wave * 1024); LAS float* sc = (LAS float*)(se + 128);
            const int r_lo = e_lo[b] >> 10, r_hi = e_hi[b] >> 10;
            int pos_lo = 0, pos_hi = 0, base = 0;
#pragma unroll
            for (int r = 0; r < 16; ++r) {
                const unsigned long long b0 = __builtin_amdgcn_ballot_w64(r_lo == r), b1 = __builtin_amdgcn_ballot_w64(r_hi == r);
                const int n0 = __builtin_popcountll(b0), n1 = __builtin_popcountll(b1);
                const int k0 = (int)__builtin_amdgcn_mbcnt_hi((unsigned)(b0 >> 32), __builtin_amdgcn_mbcnt_lo((unsigned)b0, 0u));
                const int k1 = (int)__builtin_amdgcn_mbcnt_hi((unsigned)(b1 >> 32), __builtin_amdgcn_mbcnt_lo((unsigned)b1, 0u));
                pos_lo = (r_lo == r) ? base + k0 : pos_lo; pos_hi = (r_hi == r) ? base + n0 + k1 : pos_hi;
                base += n0 + n1;
            }
            se[pos_lo] = e_lo[b]; sc[pos_lo] = c_lo[b]; se[pos_hi] = e_hi[b]; sc[pos_hi] = c_hi[b];
            e_lo[b] = se[lane]; e_hi[b] = se[64 + lane]; c_lo[b] = sc[lane]; c_hi[b] = sc[64 + lane];
        }
        __syncthreads();
        if (nloc) {
            if (threadIdx.x == 0) {
                unsigned* pc = (unsigned*)(A.ws + WS_CTL) + 12288 + ((dry ? 2 : 0) + layer) * 16 * 64 + (xb_xcc_id() & 15u) * 64;
                const unsigned want = nloc * (unsigned)(swi + 1);
                __hip_atomic_fetch_add(pc, 1u, __ATOMIC_RELAXED, __HIP_MEMORY_SCOPE_AGENT);
                for (int sp = 0; sp < 400; ++sp) { if (__hip_atomic_load(pc, __ATOMIC_RELAXED, __HIP_MEMORY_SCOPE_AGENT) >= want) break; __builtin_amdgcn_s_sleep(1); }
            }
            __syncthreads();
        }
        f32x2 acc[UP_NT][8];
#pragma unroll
        for (int b = 0; b < UP_NT; ++b)
#pragma unroll
            for (int i = 0; i < 8; ++i) acc[b][i] = (f32x2){0.f, 0.f};
#pragma unroll 1
        for (int c = 0; c < 32; ++c) {
            u32x2 wu[UP_NT][4]; float cf[UP_NT][4];
#pragma unroll
            for (int b = 0; b < UP_NT; ++b)
#pragma unroll
                for (int k = 0; k < 4; ++k) {
                    const int slot = (c & 15) * 4 + k;
                    const int ek = __builtin_amdgcn_readlane(c < 16 ? e_lo[b] : e_hi[b], slot);
                    cf[b][k] = __builtin_bit_cast(float, __builtin_amdgcn_readlane(__builtin_bit_cast(int, c < 16 ? c_lo[b] : c_hi[b]), slot));
                    wu[b][k] = *(const u32x2*)(WUQ + (size_t)ek * (DM / 2) + 8 * lane);
                }
#pragma unroll
            for (int b = 0; b < UP_NT; ++b)
#pragma unroll
                for (int k = 0; k < 4; ++k) {
                    const f32x2 cc = (f32x2){cf[b][k], cf[b][k]};
#pragma unroll
                    for (int q = 0; q < 2; ++q) {
                        const f32x2 v0 = __builtin_amdgcn_cvt_scalef32_pk_f32_fp4(wu[b][k][q], 1.0f, 0), v1 = __builtin_amdgcn_cvt_scalef32_pk_f32_fp4(wu[b][k][q], 1.0f, 1);
                        const f32x2 v2 = __builtin_amdgcn_cvt_scalef32_pk_f32_fp4(wu[b][k][q], 1.0f, 2), v3 = __builtin_amdgcn_cvt_scalef32_pk_f32_fp4(wu[b][k][q], 1.0f, 3);
                        acc[b][4 * q] = cc * v0 + acc[b][4 * q]; acc[b][4 * q + 1] = cc * v1 + acc[b][4 * q + 1];
                        acc[b][4 * q + 2] = cc * v2 + acc[b][4 * q + 2]; acc[b][4 * q + 3] = cc * v3 + acc[b][4 * q + 3];
                    }
                }
        }
#pragma unroll
        for (int b = 0; b < UP_NT; ++b) {
            const int t = t0 + b;
            f32x4 x[4];
            { const u32x4 xa = *(const u32x4*)(X + (size_t)t * DM + 16 * lane), xb2 = *(const u32x4*)(X + (size_t)t * DM + 16 * lane + 8);
              x[0] = (f32x4){bf_lo(xa.x), bf_hi(xa.x), bf_lo(xa.y), bf_hi(xa.y)}; x[1] = (f32x4){bf_lo(xa.z), bf_hi(xa.z), bf_lo(xa.w), bf_hi(xa.w)};
              x[2] = (f32x4){bf_lo(xb2.x), bf_hi(xb2.x), bf_lo(xb2.y), bf_hi(xb2.y)}; x[3] = (f32x4){bf_lo(xb2.z), bf_hi(xb2.z), bf_lo(xb2.w), bf_hi(xb2.w)}; }
            float ss = 0.f;
#pragma unroll
            for (int j = 0; j < 4; ++j) { x[j] = x[j] + (f32x4){acc[b][2 * j][0], acc[b][2 * j][1], acc[b][2 * j + 1][0], acc[b][2 * j + 1][1]};
                ss += (x[j][0] * x[j][0] + x[j][1] * x[j][1]) + (x[j][2] * x[j][2] + x[j][3] * x[j][3]); }
            const float r2 = __builtin_amdgcn_rsqf(wave_sum(ss) * (1.0f / DM) + RMS_EPS);
            if (layer == 0) {
                bf16_t* ox = XO + (size_t)t * DM + 16 * lane; bf16_t* on = XN + (size_t)t * DM + 16 * lane;
                u32x4 w; w.x = cvt_pk_bf16(x[0][0], x[0][1]); w.y = cvt_pk_bf16(x[0][2], x[0][3]); w.z = cvt_pk_bf16(x[1][0], x[1][1]); w.w = cvt_pk_bf16(x[1][2], x[1][3]);
                *(u32x4*)ox = w;
                w.x = cvt_pk_bf16(x[2][0], x[2][1]); w.y = cvt_pk_bf16(x[2][2], x[2][3]); w.z = cvt_pk_bf16(x[3][0], x[3][1]); w.w = cvt_pk_bf16(x[3][2], x[3][3]);
                *(u32x4*)(ox + 8) = w;
                w.x = cvt_pk_bf16(x[0][0] * r2, x[0][1] * r2); w.y = cvt_pk_bf16(x[0][2] * r2, x[0][3] * r2); w.z = cvt_pk_bf16(x[1][0] * r2, x[1][1] * r2); w.w = cvt_pk_bf16(x[1][2] * r2, x[1][3] * r2);
                *(u32x4*)on = w;
                w.x = cvt_pk_bf16(x[2][0] * r2, x[2][1] * r2); w.y = cvt_pk_bf16(x[2][2] * r2, x[2][3] * r2); w.z = cvt_pk_bf16(x[3][0] * r2, x[3][1] * r2); w.w = cvt_pk_bf16(x[3][2] * r2, x[3][3] * r2);
                *(u32x4*)(on + 8) = w;
            } else {
                float* xo = FO + (size_t)t * DM + 16 * lane;
#pragma unroll
                for (int j = 0; j < 4; ++j) { const f32x4 g = *(const f32x4*)(gfin + 16 * lane + 4 * j); *(f32x4*)(xo + 4 * j) = x[j] * r2 * g; }
            }
        }
    }
}

__device__ __forceinline__ void sgu_phase(const Args& A, LAS unsigned char* lds, int vcu, int G, int wave, int lane) {
    const bf16_t* U = (const bf16_t*)(A.ws + WS_PROJ);
    const bf16_t* VT = (const bf16_t*)(A.ws + WS_PROJ) + (size_t)T * DM;
    const float* SQ2 = (const float*)(A.ws + WS_SQ2);
    const bf16_t* WS_ = (const bf16_t*)(A.ws + WS_WS);
    bf16_t* Gt = (bf16_t*)(A.ws + WS_MIX);
    const float* c_norm = A.in[9]; const float* b_s = A.in[11];
    const int fr = lane & 15, fq = lane >> 4, tid = threadIdx.x;
    constexpr int WROW = 272, WBUF = 128 * WROW;
    LAS float* lrs = (LAS float*)(lds + 2 * WBUF);
    for (int ch = vcu; ch < T / 128; ch += G) {
        __syncthreads();
        if (tid < 128) {
            const f32x4* sp = (const f32x4*)(SQ2 + (size_t)(ch * 128 + tid) * 16);
            const f32x4 a = sp[0], b = sp[1], c = sp[2], d = sp[3];
            const float sm = ((a[0] + a[1]) + (a[2] + a[3])) + ((b[0] + b[1]) + (b[2] + b[3])) + ((c[0] + c[1]) + (c[2] + c[3])) + ((d[0] + d[1]) + (d[2] + d[3]));
            lrs[tid] = __builtin_amdgcn_rsqf(sm * (1.0f / DM) + RMS_EPS);
        }
        { const u32x4* wp = (const u32x4*)(WS_ + (size_t)(tid >> 2) * 128 + (tid & 3) * 32);
          LAS u32x4* lp = (LAS u32x4*)(lds + (tid >> 2) * WROW + (tid & 3) * 64);
#pragma unroll
          for (int k = 0; k < 4; ++k) lp[k] = wp[k]; }
        __syncthreads();
#pragma unroll 1
        for (int g = 0; g < 8; ++g) {
            LAS unsigned char* wcur = lds + (g & 1) * WBUF;
            u32x4 wn[4];
            if (g + 1 < 8) { const u32x4* wp = (const u32x4*)(WS_ + (size_t)(g + 1) * 128 * 128 + (size_t)(tid >> 2) * 128 + (tid & 3) * 32);
#pragma unroll
                for (int k = 0; k < 4; ++k) wn[k] = wp[k]; }
            const int c = g * 128 + 16 * wave + fr;
            bf16x8 Vf[4];
#pragma unroll
            for (int s = 0; s < 4; ++s) {
                const u32x4 v = *(const u32x4*)(VT + (size_t)ch * (DM * 128) + (size_t)c * 128 + 32 * s + 8 * fq);
                const f32x4 ra = *(const LAS f32x4*)(lrs + 32 * s + 8 * fq), rb = *(const LAS f32x4*)(lrs + 32 * s + 8 * fq + 4);
                u32x4 w;
                w[0] = cvt_pk_bf16(bf_lo(v[0]) * ra[0], bf_hi(v[0]) * ra[1]); w[1] = cvt_pk_bf16(bf_lo(v[1]) * ra[2], bf_hi(v[1]) * ra[3]);
                w[2] = cvt_pk_bf16(bf_lo(v[2]) * rb[0], bf_hi(v[2]) * rb[1]); w[3] = cvt_pk_bf16(bf_lo(v[3]) * rb[2], bf_hi(v[3]) * rb[3]);
                Vf[s] = __builtin_bit_cast(bf16x8, w);
            }
            const int c0 = g * 128 + 16 * wave + 4 * fq;
            u32x2 uu[8];
#pragma unroll
            for (int pb = 0; pb < 8; ++pb) uu[pb] = *(const u32x2*)(U + (size_t)(ch * 128 + pb * 16 + fr) * DM + c0);
            f32x4 acc[8];
#pragma unroll
            for (int pb = 0; pb < 8; ++pb) acc[pb] = (f32x4){0.f, 0.f, 0.f, 0.f};
#pragma unroll
            for (int s = 0; s < 4; ++s) {
#pragma unroll
                for (int pb = 0; pb < 8; ++pb) {
                    const bf16x8 Wf = *(const LAS bf16x8*)(wcur + (pb * 16 + fr) * WROW + 64 * s + 16 * fq);
                    acc[pb] = __builtin_amdgcn_mfma_f32_16x16x32_bf16(Vf[s], Wf, acc[pb], 0, 0, 0);
                }
                asm volatile("" ::: "memory");
            }
            const f32x4 cn = *(const f32x4*)(c_norm + c0);
#pragma unroll
            for (int pb = 0; pb < 8; ++pb) {
                const int p = pb * 16 + fr;
                const float bs = b_s[g * 128 + p];
                const f32x4 mx = acc[pb] * cn + bs;
                u32x2 w; w.x = cvt_pk_bf16(bf_lo(uu[pb].x) * mx[0], bf_hi(uu[pb].x) * mx[1]); w.y = cvt_pk_bf16(bf_lo(uu[pb].y) * mx[2], bf_hi(uu[pb].y) * mx[3]);
                *(u32x2*)(Gt + (size_t)(ch * 128 + p) * DM + c0) = w;
            }
            if (g + 1 < 8) { LAS u32x4* lp = (LAS u32x4*)(lds + ((g + 1) & 1) * WBUF + (tid >> 2) * WROW + (tid & 3) * 64);
#pragma unroll
                for (int k = 0; k < 4; ++k) lp[k] = wn[k]; }
            __syncthreads();
        }
    }
}

constexpr int NPHASE = 14;
__global__ void __launch_bounds__(NWAVES * 64, 2) mk_fwd(Args args) {
    extern __shared__ __attribute__((aligned(16))) unsigned char lds_raw[];
    LAS unsigned char* lds = (LAS unsigned char*)lds_raw;
    const int tid = threadIdx.x, lane = tid & 63, wave = __builtin_amdgcn_readfirstlane(tid >> 6);
    const int G = gridDim.x; const int bx = blockIdx.x;
    const int vcu = (G % 8 == 0) ? (bx % 8) * (G / 8) + bx / 8 : bx;
    unsigned char* ws = args.ws;
    const int lo = args.ph_lo, hi = args.ph_hi;
#ifndef REP_MASK
#define REP_MASK 0u
#endif
#define REP(k) (((REP_MASK >> (k)) & 1u) != 0u)
#ifndef PH_MASK
#define PH_MASK 0xffffffffu
#endif
#define IN(k) (((PH_MASK >> (k)) & 1u) && lo <= (k) && (k) < hi)
    cg::grid_group grid = cg::this_grid();
    {
        volatile LAS unsigned* stw = (volatile LAS unsigned*)(lds + LDS_BARST);
        if (tid < 2) stw[tid] = 0u;
        __syncthreads();
    }
    const XcdBarrier xbar = xcd_barrier_post((unsigned*)(ws + WS_CTL) + 1024, (volatile LAS unsigned*)(lds + LDS_BARST));
    if (lo < 0) grid.sync();
#define SEAM(k) do { if (IN(k) && IN((k) + 1)) xcd_barrier(xbar); } while (0)
#define RSYNC() xcd_barrier(xbar)
    bf16_t* XA = (bf16_t*)(ws + WS_XA); bf16_t* PROJ = (bf16_t*)(ws + WS_PROJ); bf16_t* MIX = (bf16_t*)(ws + WS_MIX);
    float* SQ = (float*)(ws + WS_SQ); float* SQ2 = (float*)(ws + WS_SQ2);

    if (IN(0)) { if (REP(0)) { p0_prologue(args, lds, vcu, G, wave, lane); RSYNC(); } p0_prologue(args, lds, vcu, G, wave, lane); }
    SEAM(0);
    if (IN(1)) { if (REP(1)) { { pg8::Gemm g{XA, (const bf16_t*)(ws + WS_WABIN), T, 2048, DM}; pg8::StaticOrder S; S.init(T, 2048, G, bx);
        pg8::EpiProj E{PROJ, (const float*)(ws + WS_TAB)}; pg8::gemm_phase(lds, g, S, E); } RSYNC(); } { pg8::Gemm g{XA, (const bf16_t*)(ws + WS_WABIN), T, 2048, DM}; pg8::StaticOrder S; S.init(T, 2048, G, bx);
        pg8::EpiProj E{PROJ, (const float*)(ws + WS_TAB)}; pg8::gemm_phase(lds, g, S, E); } }
    SEAM(1);
    if (IN(2)) { if (REP(2)) { attn_phase(args, lds, vcu, G, wave, lane); RSYNC(); } attn_phase(args, lds, vcu, G, wave, lane); }
    SEAM(2);
    if (IN(3)) { if (REP(3)) { mixab_phase(args, vcu, G, wave, lane); RSYNC(); } mixab_phase(args, vcu, G, wave, lane); }
    SEAM(3);
    if (IN(4)) { if (REP(4)) { { pg8::Gemm g{MIX, (const bf16_t*)(ws + WS_WABOUT), T, 1024, DM}; pg8::StaticOrder S; S.init(T, 1024, G, bx);
        pg8::EpiRes E{args.in[0], nullptr, XA, SQ}; pg8::gemm_phase(lds, g, S, E); } RSYNC(); } { pg8::Gemm g{MIX, (const bf16_t*)(ws + WS_WABOUT), T, 1024, DM}; pg8::StaticOrder S; S.init(T, 1024, G, bx);
        pg8::EpiRes E{args.in[0], nullptr, XA, SQ}; pg8::gemm_phase(lds, g, S, E); } }
    SEAM(4);
    if (IN(5) && REP(19)) { pg8::Gemm g{XA, (const bf16_t*)(ws + WS_WQ0), T, 2048, DM}; pg8::StaticOrder S; S.init(T, 2048, G, bx);
        pg8::EpiScaled E{PROJ, NPROJ, SQ, true, true}; pg8::gemm_phase(lds, g, S, E); RSYNC(); }
    if (IN(5)) { if (REP(5)) { { pg8::Gemm g{XA, (const bf16_t*)(ws + WS_WQ0), T, 2048, DM}; pg8::StaticOrder S; S.init(T, 2048, G, bx);
        pg8::EpiScaled E{PROJ, NPROJ, SQ, false, true}; pg8::gemm_phase(lds, g, S, E); } RSYNC(); } { pg8::Gemm g{XA, (const bf16_t*)(ws + WS_WQ0), T, 2048, DM}; pg8::StaticOrder S; S.init(T, 2048, G, bx);
        pg8::EpiScaled E{PROJ, NPROJ, SQ, false, true}; pg8::gemm_phase(lds, g, S, E); } }
    SEAM(5);
    if (IN(6)) { if (REP(6)) { topk_phase(args, lds, 0, vcu, G, wave, lane); RSYNC(); } topk_phase(args, lds, 0, vcu, G, wave, lane); }
    SEAM(6);
    if (IN(7)) { if (REP(7)) { expert_up_phase(args, lds, 0, vcu, G, wave, lane, true); RSYNC(); } if (REP(14)) { expert_down_phase(args, lds, 0, G, bx, wave, lane, 1); RSYNC(); } if (REP(15)) { expert_down_phase(args, lds, 0, G, bx, wave, lane, 2); RSYNC(); } if (REP(16)) { expert_down_phase(args, lds, 0, G, bx, wave, lane, 5); RSYNC(); } if (REP(17)) { expert_down_phase(args, lds, 0, G, bx, wave, lane, 3); RSYNC(); } if (REP(18)) { expert_down_phase(args, lds, 0, G, bx, wave, lane, 6); RSYNC(); } expert_down_phase(args, lds, 0, G, bx, wave, lane); RSYNC(); expert_up_phase(args, lds, 0, vcu, G, wave, lane, false, xbar.st[0]); }
    SEAM(7);
    if (IN(8)) { if (REP(8)) { { pg8::Gemm g{(const bf16_t*)(ws + WS_OP), (const bf16_t*)(ws + WS_WCIN), T, 2048, DM}; pg8::StaticOrder S; S.init(T, 2048, G, bx);
        pg8::EpiGelu E{PROJ, PROJ + (size_t)T * DM, SQ2}; pg8::gemm_phase(lds, g, S, E); } RSYNC(); } { pg8::Gemm g{(const bf16_t*)(ws + WS_OP), (const bf16_t*)(ws + WS_WCIN), T, 2048, DM}; pg8::StaticOrder S; S.init(T, 2048, G, bx);
        pg8::EpiGelu E{PROJ, PROJ + (size_t)T * DM, SQ2}; pg8::gemm_phase(lds, g, S, E); } }
    SEAM(8);
    if (IN(9)) { if (REP(9)) { sgu_phase(args, lds, vcu, G, wave, lane); RSYNC(); } sgu_phase(args, lds, vcu, G, wave, lane); }
    SEAM(9);
    if (IN(10)) { if (REP(10)) { { pg8::Gemm g{MIX, (const bf16_t*)(ws + WS_WCOUT), T, 1024, DM}; pg8::StaticOrder S; S.init(T, 1024, G, bx);
        pg8::EpiRes E{nullptr, XA, XA, SQ}; pg8::gemm_phase(lds, g, S, E); } RSYNC(); } { pg8::Gemm g{MIX, (const bf16_t*)(ws + WS_WCOUT), T, 1024, DM}; pg8::StaticOrder S; S.init(T, 1024, G, bx);
        pg8::EpiRes E{nullptr, XA, XA, SQ}; pg8::gemm_phase(lds, g, S, E); } }
    SEAM(10);
    if (IN(11)) { if (REP(11)) { { pg8::Gemm g{XA, (const bf16_t*)(ws + WS_WQ1), T, 2048, DM}; pg8::StaticOrder S; S.init(T, 2048, G, bx);
        pg8::EpiScaled E{PROJ, NPROJ, SQ, false, true}; pg8::gemm_phase(lds, g, S, E); } RSYNC(); } { pg8::Gemm g{XA, (const bf16_t*)(ws + WS_WQ1), T, 2048, DM}; pg8::StaticOrder S; S.init(T, 2048, G, bx);
        pg8::EpiScaled E{PROJ, NPROJ, SQ, false, true}; pg8::gemm_phase(lds, g, S, E); } }
    SEAM(11);
    if (IN(12)) { if (REP(12)) { topk_phase(args, lds, 1, vcu, G, wave, lane); RSYNC(); } topk_phase(args, lds, 1, vcu, G, wave, lane); }
    SEAM(12);
    if (IN(13)) { if (REP(13)) { expert_up_phase(args, lds, 1, vcu, G, wave, lane, true); RSYNC(); } expert_down_phase(args, lds, 1, G, bx, wave, lane); RSYNC(); expert_up_phase(args, lds, 1, vcu, G, wave, lane, false, xbar.st[0]); }
#undef IN
#undef SEAM
}

extern "C" void kernel_launch(void* const* d_in, const int* in_sizes, int n_in, void* d_out, int out_size, void* d_ws, size_t ws_size, hipStream_t stream) {
    static int grid = 0;
    if (grid == 0) {
        if (n_in != 17 || in_sizes[0] != T * DM || out_size != T * DM || ws_size < WS_END) {
            fprintf(stderr, "kernel_launch: unexpected shapes: n_in %d in0 %d out %d ws %zu (need %zu)\n", n_in, n_in > 0 ? in_sizes[0] : -1, out_size, ws_size, (size_t)WS_END); grid = -1; return; }
        int dev = 0, cus = 0, per_cu = 0;
        hipGetDevice(&dev);
        hipDeviceGetAttribute(&cus, hipDeviceAttributeMultiprocessorCount, dev);
        hipFuncSetAttribute((const void*)mk_fwd, hipFuncAttributeMaxDynamicSharedMemorySize, LDS_BYTES);
        hipOccupancyMaxActiveBlocksPerMultiprocessor(&per_cu, (const void*)mk_fwd, NWAVES * 64, LDS_BYTES);
        if (per_cu < 1) { fprintf(stderr, "kernel_launch: occupancy query says %d blocks per CU\n", per_cu); per_cu = 1; }
        (void)hipGetLastError();
        grid = cus;
    }
    if (grid < 0) return;
    if (hipMemsetAsync((char*)d_ws + WS_CTL, 0, 64 * 1024, stream) != hipSuccess) { fprintf(stderr, "kernel_launch: memset of control words failed\n"); return; }
    Args a{};
    for (int i = 0; i < 17; ++i) a.in[i] = (const float*)d_in[i];
    a.out = (float*)d_out; a.ws = (unsigned char*)d_ws;
    a.ph_lo = 0; a.ph_hi = NPHASE;
    void* kargs[] = {&a};
    hipError_t e = hipLaunchCooperativeKernel((const void*)mk_fwd, dim3(grid), dim3(NWAVES * 64), kargs, LDS_BYTES, stream);
    if (e != hipSuccess) fprintf(stderr, "cooperative launch failed: %s (grid %d)\n", hipGetErrorString(e), grid);
}
```

```cpp
#include <hip/hip_runtime.h>
#include <hip/hip_cooperative_groups.h>
#include <cstdio>
#include <cstdint>
namespace cg = cooperative_groups;


constexpr int BATCH = 32, SEQ = 2048, DM = 1024, T = BATCH * SEQ;
constexpr int NPROJ = 2048;
constexpr float RMS_EPS = 1e-6f;
constexpr float LOG2E = 1.4426950408889634f;
constexpr float QSCALE = 0.125f * LOG2E;
constexpr int NEXP = 16384;

constexpr size_t MiB = 1u << 20;
constexpr size_t WS_CTL = 0;
constexpr size_t WS_TAB = 1 * MiB;
constexpr size_t WS_SQ = 2 * MiB;
constexpr size_t WS_SQ2 = 6 * MiB;
constexpr size_t WS_WPOOL = 10 * MiB;
constexpr size_t WS_WS = 10 * MiB + 512 * 1024;
constexpr size_t WS_SK = 11 * MiB;
constexpr size_t WS_WABIN = 12 * MiB, WS_WABOUT = 16 * MiB, WS_WCIN = 18 * MiB, WS_WCOUT = 22 * MiB, WS_WQ0 = 24 * MiB, WS_WQ1 = 28 * MiB;
constexpr size_t WS_WDQ = 32 * MiB;
constexpr size_t WS_WUQ = 64 * MiB;
constexpr size_t WS_SDU = 96 * MiB;
constexpr size_t WS_XS = 97 * MiB;
constexpr size_t WS_XQ = 936 * MiB;
constexpr size_t WS_XA = 160 * MiB;
constexpr size_t WS_PROJ = 288 * MiB;
constexpr size_t WS_MIX = 544 * MiB;
constexpr size_t WS_EXP = 672 * MiB;
constexpr size_t WS_G16 = 688 * MiB;
constexpr size_t WS_GATE = 704 * MiB;
constexpr size_t WS_OP = 736 * MiB;
constexpr size_t WS_LSE = 928 * MiB;
constexpr size_t WS_END = 1000 * MiB;

#define LAS __attribute__((address_space(3)))
typedef unsigned short bf16_t;
typedef short bf16x8 __attribute__((ext_vector_type(8)));
typedef short s16x4 __attribute__((ext_vector_type(4)));
typedef float f32x2 __attribute__((ext_vector_type(2)));
typedef float f32x4 __attribute__((ext_vector_type(4)));
typedef float f32x16 __attribute__((ext_vector_type(16)));
typedef unsigned u32x2 __attribute__((ext_vector_type(2)));
typedef unsigned u32x4 __attribute__((ext_vector_type(4)));
typedef __bf16 bf16x2_t __attribute__((ext_vector_type(2)));

__device__ __forceinline__ unsigned cvt_pk_bf16(float lo, float hi) { unsigned r; asm volatile("v_cvt_pk_bf16_f32 %0, %1, %2" : "=v"(r) : "v"(lo), "v"(hi)); return r; }
__device__ __forceinline__ float bf_lo(unsigned w) { return __uint_as_float(w << 16); }
__device__ __forceinline__ float bf_hi(unsigned w) { return __uint_as_float(w & 0xffff0000u); }
__device__ __forceinline__ float dot2_bf16(unsigned w, unsigned x, float acc) { return __builtin_amdgcn_fdot2_f32_bf16(__builtin_bit_cast(bf16x2_t, w), __builtin_bit_cast(bf16x2_t, x), acc, false); }
__device__ __forceinline__ float wave_sum(float v) {
#pragma unroll
    for (int o = 1; o < 64; o <<= 1) v += __shfl_xor(v, o);
    return v;
}
__device__ __forceinline__ void lds_barrier() { asm volatile("s_waitcnt lgkmcnt(0)" ::: "memory"); __builtin_amdgcn_s_barrier(); asm volatile("" ::: "memory"); }
__device__ __forceinline__ float gelu_tanh(float x) {
    const float u = x * (0.7978845608028654f + 0.035677408136300125f * x * x);
    const float e = __builtin_amdgcn_exp2f(-2.0f * LOG2E * u);
    return x * __builtin_amdgcn_rcpf(1.0f + e);
}

namespace pg8 {
constexpr int BM = 256, BK = 64, HALF = 128, HTB = HALF * BK * 2, STAGE_BYTES = 8 * HTB, NXCD = 8, WGM = 8;
__host__ __device__ __forceinline__ int lds_byte(int r, int c) { const int st = (r >> 4) * 2 + (c >> 5), rr = r & 15, cc = c & 31, ob = rr * 64 + cc * 2; return st * 1024 + (ob ^ (((ob >> 9) & 1) << 5)); }
__host__ __device__ __forceinline__ void stage_rc(int b, int& R, int& C) { const int st = b / 1024, sb = b % 1024, swz = sb ^ (((sb >> 9) & 1) << 5); R = (st >> 1) * 16 + swz / 64; C = (st & 1) * 32 + (swz % 64) / 2; }
__host__ __device__ __forceinline__ int perm32(int rho) { const int n = rho >> 4, i = rho & 15; return 8 * (i >> 2) + 4 * n + (i & 3); }

struct Unit { int pm, pn; };
struct Gemm { const bf16_t* A; const bf16_t* Bt; int M, N, K; };

struct StaticOrder {
    int nM, nN, nwg, G, c;
    __host__ __device__ void init(int M, int N, int G_, int c_) { nM = M / BM; nN = N / BM; nwg = nM * nN; G = G_; c = c_; }
    __host__ __device__ bool next(int i, Unit& u) const {
        const long L = (long)i * G + c; if (L >= nwg) return false;
        int wgid = (int)L; { const int q = nwg / NXCD, r = nwg % NXCD, xcd = wgid % NXCD, off = wgid / NXCD; wgid = (xcd < r ? xcd * (q + 1) : r * (q + 1) + (xcd - r) * q) + off; }
        const int nig = WGM * nN, gid = wgid / nig, fm = gid * WGM, gsz = (nM - fm) < WGM ? (nM - fm) : WGM;
        u.pm = fm + ((wgid % nig) % gsz); u.pn = (wgid % nig) / gsz; return true;
    }
};

template <class Epi>
__device__ __forceinline__ void gemm_phase(LAS unsigned char* lds, const Gemm g, const StaticOrder& S, const Epi& E) {
    const int tid = threadIdx.x, wid = __builtin_amdgcn_readfirstlane(tid >> 6), lane = tid & 63, wr = wid >> 2, wc = wid & 3, fr = lane & 15, fq = lane >> 4;
    const int K = g.K, nt = K / BK;
    unsigned voffA[2], voffB[2];
#pragma unroll
    for (int i = 0; i < 2; ++i) { int R, C; stage_rc(tid * 16 + i * 8192, R, C); const int Rb = 2 * (R & ~31) + perm32(R & 31);
        voffA[i] = (unsigned)(R * K + C) * 2u; voffB[i] = (unsigned)(Rb * K + C) * 2u; }
    const size_t kstep = (size_t)(BK * 2);
    const size_t hstep = (size_t)HALF * K * 2;
    const size_t tstep = 2 * hstep;
    const size_t bhs = (size_t)32 * K * 2;
    const unsigned ldsw = (unsigned)wid * 1024u;
    const int aoff = lds_byte(wr * 64 + fr, fq * 8), boff = lds_byte(wc * 32 + fr, fq * 8);
#define PG8_SA(b, h) (((b) * 2 + (h)) * HTB)
#define PG8_SB(b, h) ((4 + (b) * 2 + (h)) * HTB)
#define PG8_STAGE(bufoff, gbase, voff) do { _Pragma("unroll") for (int _i = 0; _i < 2; ++_i) \
        __builtin_amdgcn_global_load_lds((const unsigned*)((const char*)(gbase) + (voff)[_i]), (LAS unsigned*)(lds + (bufoff) + ldsw + _i * 8192), 16, 0, 0); } while (0)
#define PG8_LDA(dst, b, h) do { _Pragma("unroll") for (int m = 0; m < 4; ++m) _Pragma("unroll") for (int k = 0; k < 2; ++k) dst[m][k] = *(const LAS bf16x8*)(lds + PG8_SA(b, h) + aoff + m * 2048 + k * 1024); } while (0)
#define PG8_LDB(dst, b, h) do { _Pragma("unroll") for (int n = 0; n < 2; ++n) _Pragma("unroll") for (int k = 0; k < 2; ++k) dst[n][k] = *(const LAS bf16x8*)(lds + PG8_SB(b, h) + boff + n * 2048 + k * 1024); } while (0)
#define PG8_MMA(ai, bj, At, Bt) do { __builtin_amdgcn_s_setprio(1); _Pragma("unroll") for (int m = 0; m < 4; ++m) _Pragma("unroll") for (int n = 0; n < 2; ++n) _Pragma("unroll") for (int k = 0; k < 2; ++k) \
        acc[ai][bj][m][n] = __builtin_amdgcn_mfma_f32_16x16x32_bf16(Bt[n][k], At[m][k], acc[ai][bj][m][n], 0, 0, 0); __builtin_amdgcn_s_setprio(0); } while (0)
#define PG8_WAIT_V(n) asm volatile("s_waitcnt vmcnt(" #n ")" ::: "memory")
#define PG8_WAIT_L(n) asm volatile("s_waitcnt lgkmcnt(" #n ")" ::: "memory")
#define PG8_WAIT_V_EPI(f) asm volatile("s_cmp_lg_u32 %0, 0\n\ts_cbranch_scc1 .Lwv24_%=\n\ts_waitcnt vmcnt(8)\n\ts_branch .Lwvend_%=\n.Lwv24_%=:\n\ts_waitcnt vmcnt(24)\n.Lwvend_%=:" :: "s"(f) : "memory", "scc")
#define PG8_BAR __builtin_amdgcn_s_barrier()
#define PG8_SCHED __builtin_amdgcn_sched_barrier(0)
    Unit cur, nxt; int ui = 0;
    if (!S.next(0, cur)) return;
    f32x4 acc[2][2][4][2];
#pragma unroll
    for (int a = 0; a < 2; ++a)
#pragma unroll
        for (int b = 0; b < 2; ++b)
#pragma unroll
            for (int m = 0; m < 4; ++m)
#pragma unroll
                for (int n = 0; n < 2; ++n) acc[a][b][m][n] = (f32x4){0.f, 0.f, 0.f, 0.f};
    bf16x8 At[4][2], B0[2][2], B1[2][2];
    const char* cA = (const char*)g.A + (size_t)cur.pm * tstep; const char* cB = (const char*)g.Bt + (size_t)cur.pn * tstep;
    PG8_STAGE(PG8_SB(0, 0), cB, voffB); PG8_STAGE(PG8_SB(0, 1), cB + bhs, voffB); PG8_STAGE(PG8_SA(0, 0), cA, voffA); PG8_STAGE(PG8_SA(0, 1), cA + hstep, voffA);
    if (wr == 1) PG8_BAR;
    PG8_WAIT_V(2); PG8_BAR;
    PG8_STAGE(PG8_SB(1, 0), cB + kstep, voffB); PG8_STAGE(PG8_SA(1, 0), cA + kstep, voffA); PG8_STAGE(PG8_SB(1, 1), cB + bhs + kstep, voffB);
    PG8_WAIT_V(6); PG8_BAR;
    for (;;) {
        const bool has_next = S.next(ui + 1, nxt);
        const char* nA = has_next ? (const char*)g.A + (size_t)nxt.pm * tstep : cA; const char* nB = has_next ? (const char*)g.Bt + (size_t)nxt.pn * tstep : cB;
        for (int t = 0; t < nt; t += 2) {
            const bool last = (t == nt - 2);
            const char* a1 = cA + (size_t)(t + 1) * kstep;
            const char* a2 = last ? nA : cA + (size_t)(t + 2) * kstep; const char* b2 = last ? nB : cB + (size_t)(t + 2) * kstep;
            const char* a3 = a2 + kstep; const char* b3 = b2 + kstep;
            const int after_epi = __builtin_amdgcn_readfirstlane((t == 0 ? 1 : 0) & (ui > 0 ? 1 : 0));
            PG8_LDB(B0, 0, 0); PG8_LDB(B1, 0, 1); PG8_SCHED; PG8_LDA(At, 0, 0); PG8_STAGE(PG8_SA(1, 1), a1 + hstep, voffA);
            PG8_WAIT_V_EPI(after_epi);
            PG8_WAIT_L(0); PG8_BAR; PG8_MMA(0, 0, At, B0); PG8_MMA(0, 1, At, B1); PG8_BAR; PG8_SCHED;
            PG8_LDA(At, 0, 1); PG8_STAGE(PG8_SB(0, 0), b2, voffB); PG8_STAGE(PG8_SB(0, 1), b2 + bhs, voffB); PG8_STAGE(PG8_SA(0, 0), a2, voffA);
            PG8_WAIT_V_EPI(after_epi);
            PG8_WAIT_L(0); PG8_BAR; PG8_MMA(1, 0, At, B0); PG8_MMA(1, 1, At, B1); PG8_BAR; PG8_SCHED;
            PG8_LDB(B0, 1, 0); PG8_LDB(B1, 1, 1); PG8_SCHED; PG8_LDA(At, 1, 0); PG8_STAGE(PG8_SA(0, 1), a2 + hstep, voffA);
            PG8_WAIT_V(8); PG8_WAIT_L(0); PG8_BAR; PG8_MMA(0, 0, At, B0); PG8_MMA(0, 1, At, B1); PG8_BAR; PG8_SCHED;
            PG8_LDA(At, 1, 1); PG8_STAGE(PG8_SB(1, 0), b3, voffB); PG8_STAGE(PG8_SB(1, 1), b3 + bhs, voffB); PG8_STAGE(PG8_SA(1, 0), a3, voffA);
            PG8_WAIT_V(8); PG8_WAIT_L(0); PG8_BAR; PG8_MMA(1, 0, At, B0); PG8_MMA(1, 1, At, B1); PG8_BAR; PG8_SCHED;
        }
        if (wr == 0) PG8_BAR;
        E(acc, cur, wr, wc, fr, fq);
        if (!has_next) break;
#pragma unroll
        for (int a = 0; a < 2; ++a)
#pragma unroll
            for (int b = 0; b < 2; ++b)
#pragma unroll
                for (int m = 0; m < 4; ++m)
#pragma unroll
                    for (int n = 0; n < 2; ++n) acc[a][b][m][n] = (f32x4){0.f, 0.f, 0.f, 0.f};
        cur = nxt; cA = nA; cB = nB; ++ui;
        if (wr == 1) PG8_BAR;
    }
    PG8_WAIT_V(0);
    PG8_BAR;
#undef PG8_SA
#undef PG8_SB
#undef PG8_STAGE
#undef PG8_LDA
#undef PG8_LDB
#undef PG8_MMA
#undef PG8_WAIT_V
#undef PG8_WAIT_L
#undef PG8_WAIT_V_EPI
#undef PG8_BAR
#undef PG8_SCHED
}

struct EpiProj {
    bf16_t* O; const float* tab;
    __device__ __forceinline__ void operator()(const f32x4 (&acc)[2][2][4][2], const Unit& u, int wr, int wc, int fr, int fq) const {
        const int row0 = u.pm * BM + wr * 64 + fr, col0 = u.pn * BM + wc * 64 + 8 * fq;
        const bool rot = (u.pn < 4);
        const float sc = (u.pn < 2) ? QSCALE : 1.f;
#pragma unroll
        for (int am = 0; am < 4; ++am) {
            f32x4 tt[2][4];
            if (rot) {
#pragma unroll
                for (int mm = 0; mm < 2; ++mm) { const f32x4* tp = (const f32x4*)(tab + (size_t)((row0 + (am >> 1) * HALF + (2 * (am & 1) + mm) * 16) & (SEQ - 1)) * 16); tt[mm][0] = tp[0]; tt[mm][1] = tp[1]; tt[mm][2] = tp[2]; tt[mm][3] = tp[3]; }
            }
            __builtin_amdgcn_sched_barrier(0);
#pragma unroll
            for (int mm = 0; mm < 2; ++mm) {
                const int ai = am >> 1, m = 2 * (am & 1) + mm;
                const int row = row0 + ai * HALF + m * 16;
                bf16_t* rowp = O + (size_t)row * NPROJ + col0;
                f32x4 t0, t1, t2, t3;
                if (rot) { t0 = tt[mm][0]; t1 = tt[mm][1]; t2 = tt[mm][2]; t3 = tt[mm][3]; }
#pragma unroll
                for (int bj = 0; bj < 2; ++bj) {
                    f32x4 v0 = acc[ai][bj][m][0], v1 = acc[ai][bj][m][1];
                    if (rot && bj == 0) {
                        f32x4 p0, p1;
#pragma unroll
                        for (int j = 0; j < 4; ++j) { p0[j] = __shfl_xor(v0[j], 16); p1[j] = __shfl_xor(v1[j], 16); }
                        const float sg = (fq == 0) ? -1.f : ((fq == 1) ? 1.f : 0.f);
                        const bool on = fq < 2;
                        const float c0 = on ? t0[0] : 1.f, s0 = sg * t0[1], c1 = on ? t0[2] : 1.f, s1 = sg * t0[3];
                        const float c2 = on ? t1[0] : 1.f, s2 = sg * t1[1], c3 = on ? t1[2] : 1.f, s3 = sg * t1[3];
                        const float c4 = on ? t2[0] : 1.f, s4 = sg * t2[1], c5 = on ? t2[2] : 1.f, s5 = sg * t2[3];
                        const float c6 = on ? t3[0] : 1.f, s6 = sg * t3[1], c7 = on ? t3[2] : 1.f, s7 = sg * t3[3];
                        v0[0] = v0[0] * c0 + p0[0] * s0; v0[1] = v0[1] * c1 + p0[1] * s1; v0[2] = v0[2] * c2 + p0[2] * s2; v0[3] = v0[3] * c3 + p0[3] * s3;
                        v1[0] = v1[0] * c4 + p1[0] * s4; v1[1] = v1[1] * c5 + p1[1] * s5; v1[2] = v1[2] * c6 + p1[2] * s6; v1[3] = v1[3] * c7 + p1[3] * s7;
                    }
                    v0 = v0 * sc; v1 = v1 * sc;
                    u32x4 w; w.x = cvt_pk_bf16(v0[0], v0[1]); w.y = cvt_pk_bf16(v0[2], v0[3]); w.z = cvt_pk_bf16(v1[0], v1[1]); w.w = cvt_pk_bf16(v1[2], v1[3]);
                    *(u32x4*)(rowp + bj * 32) = w;
                }
            }
            __builtin_amdgcn_sched_barrier(0);
        }
    }
};
struct EpiRes {
    const float* basef; const bf16_t* baseb; bf16_t* xb; float* sq;
    __device__ __forceinline__ void finish(const f32x4 (&acc)[2][2][4][2], int ai, int m, const f32x4 (&b)[2][2], size_t off, int row, const Unit& u, int wc, int fq) const {
        float ss = 0.f;
#pragma unroll
        for (int bj = 0; bj < 2; ++bj) {
            const f32x4 o0 = b[bj][0] + acc[ai][bj][m][0], o1 = b[bj][1] + acc[ai][bj][m][1];
            u32x4 w; w.x = cvt_pk_bf16(o0[0], o0[1]); w.y = cvt_pk_bf16(o0[2], o0[3]); w.z = cvt_pk_bf16(o1[0], o1[1]); w.w = cvt_pk_bf16(o1[2], o1[3]);
            *(u32x4*)(xb + off + bj * 32) = w;
            ss += (o0[0] * o0[0] + o0[1] * o0[1]) + (o0[2] * o0[2] + o0[3] * o0[3]) + (o1[0] * o1[0] + o1[1] * o1[1]) + (o1[2] * o1[2] + o1[3] * o1[3]);
        }
        ss += __shfl_xor(ss, 16); ss += __shfl_xor(ss, 32);
        if (fq == 0) sq[(size_t)row * 16 + u.pn * 4 + wc] = ss;
    }
    __device__ __forceinline__ void operator()(const f32x4 (&acc)[2][2][4][2], const Unit& u, int wr, int wc, int fr, int fq) const {
        const int row0 = u.pm * BM + wr * 64 + fr, col0 = u.pn * BM + wc * 64 + 8 * fq;
        if (basef) {
#pragma unroll
            for (int ai = 0; ai < 2; ++ai)
#pragma unroll
                for (int mh = 0; mh < 2; ++mh) {
                    f32x4 bb[2][2][2];
#pragma unroll
                    for (int mm = 0; mm < 2; ++mm)
#pragma unroll
                        for (int bj = 0; bj < 2; ++bj) { const float* bp = basef + (size_t)(row0 + ai * HALF + (2 * mh + mm) * 16) * DM + col0 + bj * 32; bb[mm][bj][0] = *(const f32x4*)bp; bb[mm][bj][1] = *(const f32x4*)(bp + 4); }
                    __builtin_amdgcn_sched_barrier(0);
#pragma unroll
                    for (int mm = 0; mm < 2; ++mm) { const int m = 2 * mh + mm, row = row0 + ai * HALF + m * 16; finish(acc, ai, m, bb[mm], (size_t)row * DM + col0, row, u, wc, fq); }
                    __builtin_amdgcn_sched_barrier(0);
                }
        } else {
#pragma unroll
            for (int ai = 0; ai < 2; ++ai) {
                u32x4 bw[4][2];
#pragma unroll
                for (int m = 0; m < 4; ++m)
#pragma unroll
                    for (int bj = 0; bj < 2; ++bj) bw[m][bj] = *(const u32x4*)(baseb + (size_t)(row0 + ai * HALF + m * 16) * DM + col0 + bj * 32);
                __builtin_amdgcn_sched_barrier(0);
#pragma unroll
                for (int m = 0; m < 4; ++m) {
                    const int row = row0 + ai * HALF + m * 16;
                    f32x4 b[2][2];
#pragma unroll
                    for (int bj = 0; bj < 2; ++bj) { const u32x4 t = bw[m][bj];
                        b[bj][0] = (f32x4){bf_lo(t.x), bf_hi(t.x), bf_lo(t.y), bf_hi(t.y)}; b[bj][1] = (f32x4){bf_lo(t.z), bf_hi(t.z), bf_lo(t.w), bf_hi(t.w)}; }
                    finish(acc, ai, m, b, (size_t)row * DM + col0, row, u, wc, fq);
                }
                __builtin_amdgcn_sched_barrier(0);
            }
        }
    }
};
struct EpiScaled {
    bf16_t* O; int ldc; const float* sq; bool plain; bool frag;
    __device__ __forceinline__ void operator()(const f32x4 (&acc)[2][2][4][2], const Unit& u, int wr, int wc, int fr, int fq) const {
        const int row0 = u.pm * BM + wr * 64 + fr, col0 = u.pn * BM + wc * 64 + 8 * fq;
        f32x4 pp[8];
#pragma unroll
        for (int i = 0; i < 8; ++i) pp[i] = *(const f32x4*)(sq + (size_t)(row0 + (i >> 2) * HALF + (i & 3) * 16) * 16 + 4 * fq);
        __builtin_amdgcn_sched_barrier(0);
        float rs[8];
#pragma unroll
        for (int i = 0; i < 8; ++i) { float t = (pp[i][0] + pp[i][1]) + (pp[i][2] + pp[i][3]); t += __shfl_xor(t, 16); t += __shfl_xor(t, 32);
            rs[i] = plain ? 1.f : __builtin_amdgcn_rsqf(t * (1.0f / DM) + RMS_EPS); }
#pragma unroll
        for (int ai = 0; ai < 2; ++ai)
#pragma unroll
            for (int m = 0; m < 4; ++m) {
                const int row = row0 + ai * HALF + m * 16;
                const float rstd = rs[ai * 4 + m];
                bf16_t* rowp = O + (size_t)row * ldc + col0;
#pragma unroll
                for (int bj = 0; bj < 2; ++bj) {
                    const f32x4 v0 = acc[ai][bj][m][0] * rstd, v1 = acc[ai][bj][m][1] * rstd;
                    u32x4 w; w.x = cvt_pk_bf16(v0[0], v0[1]); w.y = cvt_pk_bf16(v0[2], v0[3]); w.z = cvt_pk_bf16(v1[0], v1[1]); w.w = cvt_pk_bf16(v1[2], v1[3]);
                    if (frag) {
                        const int c = col0 + bj * 32, h = c >> 8, half = (c >> 7) & 1, hh = (c >> 6) & 1, s = (c >> 3) & 7;
                        const size_t chunk = ((((size_t)(row >> 5) * 8 + h) * 2 + half) * 8 + s) * 64 + (row & 31) + 32 * hh;
                        *(u32x4*)(O + chunk * 8) = w;
                    } else *(u32x4*)(rowp + bj * 32) = w;
                }
            }
    }
};
struct EpiGelu {
    bf16_t* U; bf16_t* VT; float* sq2;
    __device__ __forceinline__ void operator()(const f32x4 (&acc)[2][2][4][2], const Unit& u, int wr, int wc, int fr, int fq) const {
        const int row0 = u.pm * BM + wr * 64 + fr;
        if (u.pn < 4) {
            const int col0 = u.pn * BM + wc * 64 + 8 * fq;
#pragma unroll
            for (int ai = 0; ai < 2; ++ai)
#pragma unroll
                for (int m = 0; m < 4; ++m) {
                    const int row = row0 + ai * HALF + m * 16;
                    bf16_t* rowp = U + (size_t)row * DM + col0;
#pragma unroll
                    for (int bj = 0; bj < 2; ++bj) {
                        const f32x4 a0 = acc[ai][bj][m][0], a1 = acc[ai][bj][m][1];
                        u32x4 w; w.x = cvt_pk_bf16(gelu_tanh(a0[0]), gelu_tanh(a0[1])); w.y = cvt_pk_bf16(gelu_tanh(a0[2]), gelu_tanh(a0[3]));
                        w.z = cvt_pk_bf16(gelu_tanh(a1[0]), gelu_tanh(a1[1])); w.w = cvt_pk_bf16(gelu_tanh(a1[2]), gelu_tanh(a1[3]));
                        *(u32x4*)(rowp + bj * 32) = w;
                    }
                }
        } else {
            const int col0 = (u.pn - 4) * BM + wc * 64 + 8 * fq;
#pragma unroll
            for (int ai = 0; ai < 2; ++ai)
#pragma unroll
                for (int m = 0; m < 4; ++m) {
                    const int row = row0 + ai * HALF + m * 16;
                    bf16_t* rowp = VT + (size_t)row * DM + col0;
                    float ss = 0.f;
#pragma unroll
                    for (int bj = 0; bj < 2; ++bj) {
                        float g[8];
#pragma unroll
                        for (int n = 0; n < 2; ++n)
#pragma unroll
                            for (int j = 0; j < 4; ++j) { g[4 * n + j] = gelu_tanh(acc[ai][bj][m][n][j]); ss += g[4 * n + j] * g[4 * n + j]; }
                        u32x4 w; w.x = cvt_pk_bf16(g[0], g[1]); w.y = cvt_pk_bf16(g[2], g[3]); w.z = cvt_pk_bf16(g[4], g[5]); w.w = cvt_pk_bf16(g[6], g[7]);
                        *(u32x4*)(rowp + bj * 32) = w;
                    }
                    ss += __shfl_xor(ss, 16); ss += __shfl_xor(ss, 32);
                    if (fq == 0) sq2[(size_t)row * 16 + (u.pn - 4) * 4 + wc] = ss;
                }
        }
    }
};
}

constexpr int RING_BYTES = 131072;
constexpr int LDS_BYTES = 163840;
constexpr int LDS_BARST = LDS_BYTES - 64;
constexpr int NWAVES = 8;

struct Args { const float* in[17]; float* out; unsigned char* ws; int ph_lo, ph_hi; };

__device__ __forceinline__ void p0_transpose_item(const float* W, int K, int N, bf16_t* WT, const float* gk, const float* gn, LAS float* scr, int item, int lane) {
    const int nblk = N / 32, kb = item / nblk, nb = item % nblk, k0 = 64 * kb, n0 = 32 * nb;
#pragma unroll 8
    for (int i = 0; i < 32; ++i) { const int kk = 2 * i + (lane >> 5); float v = W[(size_t)(k0 + kk) * N + n0 + (lane & 31)];
        if (gk) v *= gk[k0 + kk]; if (gn) v *= gn[n0 + (lane & 31)]; scr[kk * 33 + (lane & 31)] = v; }
    asm volatile("s_waitcnt lgkmcnt(0)" ::: "memory");
    const int c = lane & 7;
#pragma unroll
    for (int j = 0; j < 4; ++j) { const int n = (lane >> 3) + 8 * j; const LAS float* s = scr + (8 * c) * 33 + n;
        u32x4 o; o.x = cvt_pk_bf16(s[0 * 33], s[1 * 33]); o.y = cvt_pk_bf16(s[2 * 33], s[3 * 33]); o.z = cvt_pk_bf16(s[4 * 33], s[5 * 33]); o.w = cvt_pk_bf16(s[6 * 33], s[7 * 33]);
        *(u32x4*)(WT + (size_t)(n0 + n) * K + k0 + 8 * c) = o; }
    asm volatile("s_waitcnt lgkmcnt(0)" ::: "memory");
}
__device__ __forceinline__ void p0_convert(const float* src, bf16_t* dst, size_t n, const float* gain, size_t gw, size_t ngw, int lane) {
    const size_t nvec = n / 8;
    for (size_t i = gw * 64 + lane; i < nvec; i += ngw * 64) {
        f32x4 a = *(const f32x4*)(src + i * 8), b = *(const f32x4*)(src + i * 8 + 4);
        if (gain) { const size_t c = (i * 8) & 1023; const f32x4 ga = *(const f32x4*)(gain + c), gb = *(const f32x4*)(gain + c + 4); a = a * ga; b = b * gb; }
        u32x4 w; w.x = cvt_pk_bf16(a[0], a[1]); w.y = cvt_pk_bf16(a[2], a[3]); w.z = cvt_pk_bf16(b[0], b[1]); w.w = cvt_pk_bf16(b[2], b[3]);
        *(u32x4*)(dst + i * 8) = w;
    }
}
__device__ __forceinline__ void rms_row_to_bf16(const float* xrow, bf16_t* orow, int lane) {
    const f32x4* xr = (const f32x4*)xrow + lane;
    f32x4 v[4]; float s = 0.f;
#pragma unroll
    for (int j = 0; j < 4; ++j) { v[j] = xr[64 * j]; s += (v[j][0] * v[j][0] + v[j][1] * v[j][1]) + (v[j][2] * v[j][2] + v[j][3] * v[j][3]); }
    const float rstd = __builtin_amdgcn_rsqf(wave_sum(s) * (1.0f / DM) + RMS_EPS);
    u32x2* o8 = (u32x2*)orow + lane;
#pragma unroll
    for (int j = 0; j < 4; ++j) { u32x2 w; w.x = cvt_pk_bf16(v[j][0] * rstd, v[j][1] * rstd); w.y = cvt_pk_bf16(v[j][2] * rstd, v[j][3] * rstd); o8[64 * j] = w; }
}

__device__ __forceinline__ void p0_prologue(const Args& A, LAS unsigned char* lds, int vcu, int G, int wave, int lane) {
    unsigned char* ws = A.ws;
    LAS float* scr = (LAS float*)(lds + wave * 16384);
    const int gw = vcu * NWAVES + wave, NGW = G * NWAVES;
    const float* norm_mix = A.in[1]; const float* norm_ffn = A.in[2];
    constexpr int I_2048 = (DM / 64) * (2048 / 32), I_1024 = (DM / 64) * (1024 / 32), I_POOL = (128 / 64) * (128 / 32);
    constexpr int NITEMS = 4 * I_2048 + 2 * I_1024 + 4 * I_POOL;
    for (int it = gw; it < NITEMS; it += NGW) {
        int r = it;
        if (r < I_2048) { p0_transpose_item(A.in[4], DM, 2048, (bf16_t*)(ws + WS_WABIN), norm_mix, nullptr, scr, r, lane); continue; } r -= I_2048;
        if (r < I_2048) { p0_transpose_item(A.in[8], DM, 2048, (bf16_t*)(ws + WS_WCIN), norm_mix + DM, nullptr, scr, r, lane); continue; } r -= I_2048;
        if (r < I_2048) { p0_transpose_item(A.in[13], DM, 2048, (bf16_t*)(ws + WS_WQ0), norm_ffn, nullptr, scr, r, lane); continue; } r -= I_2048;
        if (r < I_2048) { p0_transpose_item(A.in[13] + (size_t)DM * 2048, DM, 2048, (bf16_t*)(ws + WS_WQ1), norm_ffn + DM, nullptr, scr, r, lane); continue; } r -= I_2048;
        if (r < I_1024) { p0_transpose_item(A.in[5], DM, 1024, (bf16_t*)(ws + WS_WABOUT), nullptr, nullptr, scr, r, lane); continue; } r -= I_1024;
        if (r < I_1024) { p0_transpose_item(A.in[12], DM, 1024, (bf16_t*)(ws + WS_WCOUT), nullptr, nullptr, scr, r, lane); continue; } r -= I_1024;
        { const int g = r / I_POOL, ri = r % I_POOL;
          p0_transpose_item(A.in[6] + (size_t)g * 128 * 128, 128, 128, (bf16_t*)(ws + WS_WPOOL) + (size_t)g * 128 * 128, nullptr, A.in[7] + g * 128, scr, ri, lane); }
    }
    for (int ch = gw * 64 + lane; ch < 2 * 8 * 2 * 4 * 8 * 64; ch += NGW * 64) {
        const int ln = ch & 63, s = (ch >> 6) & 7, kb = (ch >> 9) & 3, hi = ch >> 11;
        const float* sp = A.in[14] + ((size_t)hi * 128 + kb * 32 + (ln & 31)) * 128 + 64 * (ln >> 5) + 8 * s;
        const f32x4 a = *(const f32x4*)sp, b = *(const f32x4*)(sp + 4);
        u32x4 w; w.x = cvt_pk_bf16(a[0], a[1]); w.y = cvt_pk_bf16(a[2], a[3]); w.z = cvt_pk_bf16(b[0], b[1]); w.w = cvt_pk_bf16(b[2], b[3]);
        *(u32x4*)((bf16_t*)(ws + WS_SK) + (size_t)ch * 8) = w;
    }
    p0_convert(A.in[10], (bf16_t*)(ws + WS_WS), (size_t)8 * 128 * 128, nullptr, gw, NGW, lane);
    for (int rix0 = gw; rix0 < 4 * NEXP; rix0 += 4 * NGW) {
        f32x4 v[4][4]; bool upv[4]; int rv[4]; bool okv[4];
#pragma unroll
        for (int u = 0; u < 4; ++u) {
            const int rix = rix0 + u * NGW; okv[u] = rix < 4 * NEXP;
            const int rc = okv[u] ? rix : rix0;
            upv[u] = rc >= 2 * NEXP; rv[u] = upv[u] ? rc - 2 * NEXP : rc;
            const f32x4* sp = (const f32x4*)((upv[u] ? A.in[16] : A.in[15]) + (size_t)rv[u] * DM + 16 * lane);
#pragma unroll
            for (int j = 0; j < 4; ++j) v[u][j] = sp[j];
        }
        float am[4];
#pragma unroll
        for (int u = 0; u < 4; ++u) {
            if (!upv[u]) { const f32x4* gp = (const f32x4*)(norm_ffn + (rv[u] / NEXP) * DM + 16 * lane);
#pragma unroll
                for (int j = 0; j < 4; ++j) v[u][j] = v[u][j] * gp[j]; }
            float m = 0.f;
#pragma unroll
            for (int j = 0; j < 4; ++j) m = fmaxf(m, fmaxf(fmaxf(fabsf(v[u][j][0]), fabsf(v[u][j][1])), fmaxf(fabsf(v[u][j][2]), fabsf(v[u][j][3]))));
            am[u] = m;
        }
#pragma unroll
        for (int o = 1; o < 64; o <<= 1)
#pragma unroll
            for (int u = 0; u < 4; ++u) am[u] = fmaxf(am[u], __shfl_xor(am[u], o));
#pragma unroll
        for (int u = 0; u < 4; ++u) {
            if (!okv[u]) continue;
            const float amx = fmaxf(am[u], 1e-20f); const int r = rv[u];
            {
                const float inv = 6.0f / amx;
                u32x2 w4;
#pragma unroll
                for (int q = 0; q < 2; ++q) {
                    unsigned p = 0u;
                    p = __builtin_amdgcn_cvt_scalef32_pk_fp4_f32(p, v[u][2 * q][0] * inv, v[u][2 * q][1] * inv, 1.0f, 0);
                    p = __builtin_amdgcn_cvt_scalef32_pk_fp4_f32(p, v[u][2 * q][2] * inv, v[u][2 * q][3] * inv, 1.0f, 1);
                    p = __builtin_amdgcn_cvt_scalef32_pk_fp4_f32(p, v[u][2 * q + 1][0] * inv, v[u][2 * q + 1][1] * inv, 1.0f, 2);
                    p = __builtin_amdgcn_cvt_scalef32_pk_fp4_f32(p, v[u][2 * q + 1][2] * inv, v[u][2 * q + 1][3] * inv, 1.0f, 3);
                    w4[q] = p;
                }
                *(u32x2*)(ws + (upv[u] ? WS_WUQ : WS_WDQ) + (size_t)r * (DM / 2) + 8 * lane) = w4;
                if (lane == 0) ((float*)(ws + WS_SDU))[2 * r + (upv[u] ? 1 : 0)] = amx * (1.0f / 6.0f);
            }
        }
    }
    { float* tab = (float*)(ws + WS_TAB);
      for (int e = gw * 64 + lane; e < SEQ * 8; e += NGW * 64) {
          const int pos = e >> 3, i = e & 7;
          const float inv_freq = __builtin_amdgcn_exp2f(-(float)i * (18.931568569324174f / 8.0f));
          const float ang = (float)pos * inv_freq;
          const float kq = rintf(ang * 0.6366197723675814f);
          float r = fmaf(-kq, 1.5707963705062866f, ang); r = fmaf(-kq, -4.371138828673793e-08f, r);
          const float sr = __sinf(r), cr = __cosf(r);
          const int q = ((int)kq) & 3;
          const float s = (q == 0) ? sr : (q == 1) ? cr : (q == 2) ? -sr : -cr;
          const float c = (q == 0) ? cr : (q == 1) ? -sr : (q == 2) ? -cr : sr;
          tab[2 * e] = c; tab[2 * e + 1] = s;
      } }
    for (int m0 = gw; m0 < T; m0 += 4 * NGW) {
        f32x4 v[4][4]; float s[4];
#pragma unroll
        for (int u = 0; u < 4; ++u) { const int m = (m0 + u * NGW < T) ? m0 + u * NGW : m0; const f32x4* xr = (const f32x4*)(A.in[0] + (size_t)m * DM) + lane;
#pragma unroll
            for (int j = 0; j < 4; ++j) v[u][j] = xr[64 * j]; }
#pragma unroll
        for (int u = 0; u < 4; ++u) { float q = 0.f;
#pragma unroll
            for (int j = 0; j < 4; ++j) q += (v[u][j][0] * v[u][j][0] + v[u][j][1] * v[u][j][1]) + (v[u][j][2] * v[u][j][2] + v[u][j][3] * v[u][j][3]);
            s[u] = q; }
#pragma unroll
        for (int o = 1; o < 64; o <<= 1)
#pragma unroll
            for (int u = 0; u < 4; ++u) s[u] += __shfl_xor(s[u], o);
#pragma unroll
        for (int u = 0; u < 4; ++u) {
            const int m = m0 + u * NGW; if (m >= T) continue;
            const float rstd = __builtin_amdgcn_rsqf(s[u] * (1.0f / DM) + RMS_EPS);
            u32x2* o8 = (u32x2*)((bf16_t*)(ws + WS_XA) + (size_t)m * DM) + lane;
#pragma unroll
            for (int j = 0; j < 4; ++j) { u32x2 w; w.x = cvt_pk_bf16(v[u][j][0] * rstd, v[u][j][1] * rstd); w.y = cvt_pk_bf16(v[u][j][2] * rstd, v[u][j][3] * rstd); o8[64 * j] = w; }
        }
    }
}

__device__ __forceinline__ int crow(int r, int hi) { return (r & 3) + 8 * (r >> 2) + 4 * hi; }
__device__ __forceinline__ void attn_phase(const Args& A, LAS unsigned char* lds, int vcu, int G, int wave, int lane) {
    const bf16_t* PROJ = (const bf16_t*)(A.ws + WS_PROJ);
    bf16_t* OP = (bf16_t*)(A.ws + WS_OP);
    float* LSE = (float*)(A.ws + WS_LSE);
    LAS unsigned char* vbuf = lds + wave * 17408;
    LAS unsigned char* kbuf = vbuf + 8192;
    const int r32 = lane & 31, hh = lane >> 5, i16 = lane & 15;
    for (int bh = vcu; bh < BATCH * 8; bh += G) {
        const int b = bh >> 3, h = bh & 7;
        const bf16_t* base = PROJ + (size_t)b * SEQ * NPROJ + h * 64;
        for (int ti = wave; ti < 96; ti += NWAVES) {
            const int pat = ti >> 5, sub = ti & 31;
            int dil, res, lq0;
            if (pat == 0) { dil = 1; res = 0; lq0 = sub * 64; } else if (pat == 1) { dil = 4; res = sub >> 3; lq0 = (sub & 7) * 64; } else { dil = 16; res = sub >> 1; lq0 = (sub & 1) * 64; }
            const int L = SEQ / dil;
            bf16x8 Qf[2][4];
#pragma unroll
            for (int u = 0; u < 2; ++u) { const bf16_t* qp = base + (size_t)((lq0 + 32 * u + r32) * dil + res) * NPROJ + 32 * hh;
#pragma unroll
              for (int s = 0; s < 4; ++s) Qf[u][s] = *(const bf16x8*)(qp + 8 * s); }
            float m_run[2] = {-1e30f, -1e30f}, lsum[2] = {0.f, 0.f};
            f32x16 OT[2][2];
#pragma unroll
            for (int u = 0; u < 2; ++u)
#pragma unroll
                for (int i = 0; i < 16; ++i) { OT[u][0][i] = 0.f; OT[u][1][i] = 0.f; }
            int vb = 0;
#define BLK_J(jj) (((jj) < 2) ? (jj) + 2 : ((jj) < 4 ? (jj) - 2 : (jj)))
#define BLK_OK(jj) (!((lq0 - 64 + 32 * BLK_J(jj)) + 32 <= 0 || (lq0 - 64 + 32 * BLK_J(jj)) >= L))
#define BLK_LOAD(jj) do { const int lkb_ = lq0 - 64 + 32 * BLK_J(jj); _Pragma("unroll") for (int i = 0; i < 4; ++i) { const int lk = lkb_ + i * 8 + (lane >> 3); \
                const bf16_t* rp = base + (size_t)(lk * dil + res) * NPROJ + (lane & 7) * 8; kkN[i] = *(const u32x4*)(rp + 512); vvN[i] = *(const u32x4*)(rp + 1024); } } while (0)
            u32x4 kkN[4], vvN[4];
            BLK_LOAD(0);
#pragma unroll 1
            for (int jj = 0; jj < 6; ++jj) {
                if (!BLK_OK(jj)) continue;
                const int jblk = BLK_J(jj);
                const int lk0 = lq0 - 64 + 32 * jblk;
                LAS unsigned char* vl = vbuf + vb * 4096; LAS unsigned char* kl = kbuf + vb * 4608; vb ^= 1;
#pragma unroll
                for (int i = 0; i < 4; ++i) { *(LAS u32x4*)(kl + (i * 8 + (lane >> 3)) * 144 + (lane & 7) * 16) = kkN[i];
                    *(LAS u32x4*)(vl + (i * 8 + (lane >> 3)) * 128 + (lane & 7) * 16) = vvN[i]; }
                { int nj = jj + 1; while (nj < 6 && !BLK_OK(nj)) ++nj; if (nj < 6) BLK_LOAD(nj); }
                bf16x8 Kf[4];
#pragma unroll
                for (int s = 0; s < 4; ++s) Kf[s] = *(const LAS bf16x8*)(kl + r32 * 144 + 64 * hh + 16 * s);
                bf16x8 Vf[2][2];
#pragma unroll
                for (int db = 0; db < 2; ++db)
#pragma unroll
                    for (int s = 0; s < 2; ++s) {
                        const int R0 = 16 * s + 4 * hh, C0 = 32 * db + 16 * ((lane >> 4) & 1);
                        LAS unsigned char* a0 = vl + (R0 + (i16 >> 2)) * 128 + (C0 + 4 * (i16 & 3)) * 2;
                        const s16x4 t0 = __builtin_bit_cast(s16x4, __builtin_amdgcn_ds_read_tr16_b64_v4i16((LAS s16x4*)a0));
                        const s16x4 t1 = __builtin_bit_cast(s16x4, __builtin_amdgcn_ds_read_tr16_b64_v4i16((LAS s16x4*)(a0 + 8 * 128)));
                        Vf[db][s] = (bf16x8){t0[0], t0[1], t0[2], t0[3], t1[0], t1[1], t1[2], t1[3]};
                    }
#pragma unroll
                for (int u = 0; u < 2; ++u) {
                    const int jrel = jblk - u;
                    if (jrel < 0 || jrel > 4) continue;
                    const int lq = lq0 + 32 * u + r32;
                    f32x16 st;
#pragma unroll
                    for (int i = 0; i < 16; ++i) st[i] = 0.f;
#pragma unroll
                    for (int s = 0; s < 4; ++s) st = __builtin_amdgcn_mfma_f32_32x32x16_bf16(Kf[s], Qf[u][s], st, 0, 0, 0);
                    if (jrel == 0 || jrel == 4) {
#pragma unroll
                        for (int r = 0; r < 16; ++r) {
                            const int d = lk0 + crow(r, hh) - lq;
                            st[r] = (d <= 64 && d >= -64) ? st[r] : -1e30f;
                        }
                    }
                    float mb = fmaxf(st[0], st[1]);
#pragma unroll
                    for (int r = 2; r < 16; ++r) mb = fmaxf(mb, st[r]);
                    mb = fmaxf(mb, __shfl_xor(mb, 32));
                    if (__builtin_amdgcn_ballot_w64(mb > m_run[u] + 6.0f) != 0ull) {
                        const float m_new = fmaxf(m_run[u], mb);
                        const float alpha = __builtin_amdgcn_exp2f(m_run[u] - m_new);
                        m_run[u] = m_new;
                        lsum[u] *= alpha;
#pragma unroll
                        for (int i = 0; i < 16; ++i) { OT[u][0][i] *= alpha; OT[u][1][i] *= alpha; }
                    }
                    float ps = 0.f;
#pragma unroll
                    for (int r = 0; r < 16; ++r) { st[r] = __builtin_amdgcn_exp2f(st[r] - m_run[u]); ps += st[r]; }
                    lsum[u] += ps;
#pragma unroll
                    for (int s = 0; s < 2; ++s) {
                        u32x4 w; w.x = cvt_pk_bf16(st[8 * s + 0], st[8 * s + 1]); w.y = cvt_pk_bf16(st[8 * s + 2], st[8 * s + 3]);
                        w.z = cvt_pk_bf16(st[8 * s + 4], st[8 * s + 5]); w.w = cvt_pk_bf16(st[8 * s + 6], st[8 * s + 7]);
                        const bf16x8 Pf = __builtin_bit_cast(bf16x8, w);
                        OT[u][0] = __builtin_amdgcn_mfma_f32_32x32x16_bf16(Vf[0][s], Pf, OT[u][0], 0, 0, 0);
                        OT[u][1] = __builtin_amdgcn_mfma_f32_32x32x16_bf16(Vf[1][s], Pf, OT[u][1], 0, 0, 0);
                    }
                }
                asm volatile("" ::: "memory");
            }
#undef BLK_J
#undef BLK_OK
#undef BLK_LOAD
#pragma unroll
            for (int u = 0; u < 2; ++u) {
                const float lt = lsum[u] + __shfl_xor(lsum[u], 32);
                const float inv = __builtin_amdgcn_rcpf(lt);
                const size_t row = (size_t)b * SEQ + (size_t)((lq0 + 32 * u + r32) * dil + res);
                bf16_t* op = OP + ((size_t)pat * T + row) * 512 + h * 64;
                (void)op;
                LAS unsigned char* ol = vbuf + u * 4608;
#pragma unroll
                for (int g4 = 0; g4 < 4; ++g4) {
                    u32x2 w0, w1;
                    w0.x = cvt_pk_bf16(OT[u][0][4 * g4 + 0] * inv, OT[u][0][4 * g4 + 1] * inv); w0.y = cvt_pk_bf16(OT[u][0][4 * g4 + 2] * inv, OT[u][0][4 * g4 + 3] * inv);
                    w1.x = cvt_pk_bf16(OT[u][1][4 * g4 + 0] * inv, OT[u][1][4 * g4 + 1] * inv); w1.y = cvt_pk_bf16(OT[u][1][4 * g4 + 2] * inv, OT[u][1][4 * g4 + 3] * inv);
                    *(LAS u32x2*)(ol + r32 * 144 + (8 * g4 + 4 * hh) * 2) = w0;
                    *(LAS u32x2*)(ol + r32 * 144 + (32 + 8 * g4 + 4 * hh) * 2) = w1;
                }
#pragma unroll
                for (int i = 0; i < 4; ++i) {
                    const int rr = 8 * i + (lane >> 3);
                    const u32x4 wv = *(const LAS u32x4*)(ol + rr * 144 + (lane & 7) * 16);
                    const size_t grow = (size_t)b * SEQ + (size_t)((lq0 + 32 * u + rr) * dil + res);
                    *(u32x4*)(OP + ((size_t)pat * T + grow) * 512 + h * 64 + (lane & 7) * 8) = wv;
                }
                if (hh == 0) LSE[((size_t)pat * T + row) * 8 + h] = m_run[u] + __builtin_amdgcn_logf(lt);
            }
        }
    }
}

template <int WIN>
__device__ __forceinline__ void pool_task(const bf16_t* PROJ, const bf16_t* WP, bf16_t* MIX, LAS unsigned char* pl, int g, int t0, int lane) {
    const int fr = lane & 15, fq = lane >> 4;
    constexpr int HW = WIN / 2, NR = 32 + WIN - 1, RS = 272;
    const int pos0 = t0 & (SEQ - 1);
#pragma unroll 4
    for (int i = 0; i < (NR + 3) / 4; ++i) {
        const int r = 4 * i + (lane >> 4);
        if (r < NR) { int pc = pos0 - HW + r; pc = pc < 0 ? 0 : (pc >= SEQ ? SEQ - 1 : pc);
            *(LAS u32x4*)(pl + r * RS + (lane & 15) * 16) = *(const u32x4*)(PROJ + 1536 + g * 128 + (size_t)(t0 - pos0 + pc) * NPROJ + (lane & 15) * 8); }
    }
    f32x4 acc[2][8];
#pragma unroll
    for (int m = 0; m < 2; ++m)
#pragma unroll
        for (int n = 0; n < 8; ++n) acc[m][n] = (f32x4){0.f, 0.f, 0.f, 0.f};
#pragma unroll 1
    for (int s = 0; s < 4; ++s) {
        bf16x8 Af[2];
#pragma unroll
        for (int m = 0; m < 2; ++m) {
            const int tr = m * 16 + fr, pos = pos0 + tr;
            const LAS unsigned char* rp = pl + tr * RS + (32 * s + 8 * fq) * 2;
            float sum[8];
#pragma unroll
            for (int k = 0; k < 8; ++k) sum[k] = 0.f;
            int cnt = 0;
            u32x4 self;
            constexpr int CH = WIN < 8 ? WIN : 8;
#pragma unroll
            for (int j0 = 0; j0 < WIN; j0 += CH) {
                u32x4 v[CH];
#pragma unroll
                for (int j = 0; j < CH; ++j) v[j] = *(const LAS u32x4*)(rp + (j0 + j) * RS);
#pragma unroll
                for (int j = 0; j < CH; ++j) {
                    const int p = pos - HW + j0 + j;
                    const bool ok = (p >= 0) && (p < SEQ);
                    const float f = ok ? 1.f : 0.f; cnt += ok ? 1 : 0;
                    if (j0 + j == HW) self = v[j];
#pragma unroll
                    for (int k = 0; k < 4; ++k) { sum[2 * k] += f * bf_lo(v[j][k]); sum[2 * k + 1] += f * bf_hi(v[j][k]); }
                }
                if (WIN >= 16) asm volatile("" ::: "memory");
            }
            const float ic = 1.0f / (float)cnt;
            u32x4 w;
#pragma unroll
            for (int k = 0; k < 4; ++k) w[k] = cvt_pk_bf16(sum[2 * k] * ic - bf_lo(self[k]), sum[2 * k + 1] * ic - bf_hi(self[k]));
            Af[m] = __builtin_bit_cast(bf16x8, w);
        }
#pragma unroll
        for (int n = 0; n < 8; ++n) {
            const bf16x8 Wf = *(const bf16x8*)(WP + (size_t)g * 128 * 128 + (size_t)(n * 16 + fr) * 128 + 32 * s + 8 * fq);
#pragma unroll
            for (int m = 0; m < 2; ++m) acc[m][n] = __builtin_amdgcn_mfma_f32_16x16x32_bf16(Wf, Af[m], acc[m][n], 0, 0, 0);
        }
    }
#pragma unroll
    for (int m = 0; m < 2; ++m) {
        bf16_t* rowp = MIX + (size_t)(t0 + m * 16 + fr) * DM + 512 + g * 128 + 4 * fq;
#pragma unroll
        for (int n = 0; n < 8; ++n) { u32x2 w; w.x = cvt_pk_bf16(acc[m][n][0], acc[m][n][1]); w.y = cvt_pk_bf16(acc[m][n][2], acc[m][n][3]); *(u32x2*)(rowp + n * 16) = w; }
    }
}
__device__ __forceinline__ void mixab_phase(const Args& A, LAS unsigned char* lds, int vcu, int G, int wave, int lane) {
    const bf16_t* PROJ = (const bf16_t*)(A.ws + WS_PROJ);
    const bf16_t* OP = (const bf16_t*)(A.ws + WS_OP);
    const float* LSE = (const float*)(A.ws + WS_LSE);
    const bf16_t* WP = (const bf16_t*)(A.ws + WS_WPOOL);
    bf16_t* MIX = (bf16_t*)(A.ws + WS_MIX);
    const int gw = vcu * NWAVES + wave, NGW = G * NWAVES;
    for (int it0 = gw * 4; it0 < T; it0 += NGW * 4) {
        float l0[4], l1[4], l2[4]; u32x4 a[4], bq[4], c[4];
#pragma unroll
        for (int u = 0; u < 4; ++u) {
            const int th = (it0 + u) * 8 + (lane >> 3);
            const int t = th >> 3, h = th & 7, ch = lane & 7;
            l0[u] = LSE[((size_t)0 * T + t) * 8 + h]; l1[u] = LSE[((size_t)1 * T + t) * 8 + h]; l2[u] = LSE[((size_t)2 * T + t) * 8 + h];
            const size_t o = (size_t)t * 512 + h * 64 + ch * 8;
            a[u] = *(const u32x4*)(OP + o); bq[u] = *(const u32x4*)(OP + (size_t)T * 512 + o); c[u] = *(const u32x4*)(OP + (size_t)2 * T * 512 + o);
        }
#pragma unroll
        for (int u = 0; u < 4; ++u) {
            const int th = (it0 + u) * 8 + (lane >> 3);
            const int t = th >> 3, h = th & 7, ch = lane & 7;
            const float mx = fmaxf(l0[u], fmaxf(l1[u], l2[u]));
            float w0 = __builtin_amdgcn_exp2f(l0[u] - mx), w1 = __builtin_amdgcn_exp2f(l1[u] - mx), w2 = __builtin_amdgcn_exp2f(l2[u] - mx);
            const float inv = __builtin_amdgcn_rcpf(w0 + w1 + w2); w0 *= inv; w1 *= inv; w2 *= inv;
            u32x4 r;
#pragma unroll
            for (int k = 0; k < 4; ++k) {
                const float lo = w0 * bf_lo(a[u][k]) + w1 * bf_lo(bq[u][k]) + w2 * bf_lo(c[u][k]);
                const float hi = w0 * bf_hi(a[u][k]) + w1 * bf_hi(bq[u][k]) + w2 * bf_hi(c[u][k]);
                r[k] = cvt_pk_bf16(lo, hi);
            }
            *(u32x4*)(MIX + (size_t)t * DM + h * 64 + ch * 8) = r;
        }
    }
    for (int it = gw; it < (T / 32) * 4; it += NGW) {
        const int g = it & 3, t0 = (it >> 2) * 32;
        if (g == 0) pool_task<2>(PROJ, WP, MIX, lds + wave * 13312, 0, t0, lane);
        else if (g == 1) pool_task<4>(PROJ, WP, MIX, lds + wave * 13312, 1, t0, lane);
        else if (g == 2) pool_task<8>(PROJ, WP, MIX, lds + wave * 13312, 2, t0, lane);
        else pool_task<16>(PROJ, WP, MIX, lds + wave * 13312, 3, t0, lane);
    }
}

#define CE_DESC(x, a, b) do { const float _hi = fmaxf(x[a], x[b]); x[b] = fminf(x[a], x[b]); x[a] = _hi; } while (0)
#define CE_ASC(x, a, b)  do { const float _lo = fminf(x[a], x[b]); x[b] = fmaxf(x[a], x[b]); x[a] = _lo; } while (0)
__device__ __forceinline__ void bitonic_merge16_desc(float (&x)[16]) {
#pragma unroll
    for (int j = 8; j >= 1; j >>= 1)
#pragma unroll
        for (int i = 0; i < 16; ++i) { const int l = i ^ j; if (l > i) CE_DESC(x, i, l); }
}
__device__ __forceinline__ void bitonic_sort16_desc(float (&x)[16]) {
    CE_DESC(x,0,1);CE_DESC(x,2,3);CE_DESC(x,0,2);CE_DESC(x,1,3);CE_DESC(x,1,2);CE_DESC(x,4,5);CE_DESC(x,6,7);CE_DESC(x,4,6);CE_DESC(x,5,7);CE_DESC(x,5,6);CE_DESC(x,0,4);CE_DESC(x,2,6);CE_DESC(x,2,4);CE_DESC(x,1,5);CE_DESC(x,3,7);CE_DESC(x,3,5);
    CE_DESC(x,1,2);CE_DESC(x,3,4);CE_DESC(x,5,6);CE_DESC(x,8,9);CE_DESC(x,10,11);CE_DESC(x,8,10);CE_DESC(x,9,11);CE_DESC(x,9,10);CE_DESC(x,12,13);CE_DESC(x,14,15);CE_DESC(x,12,14);CE_DESC(x,13,15);CE_DESC(x,13,14);CE_DESC(x,8,12);CE_DESC(x,10,14);CE_DESC(x,10,12);
    CE_DESC(x,9,13);CE_DESC(x,11,15);CE_DESC(x,11,13);CE_DESC(x,9,10);CE_DESC(x,11,12);CE_DESC(x,13,14);CE_DESC(x,0,8);CE_DESC(x,4,12);CE_DESC(x,4,8);CE_DESC(x,2,10);CE_DESC(x,6,14);CE_DESC(x,6,10);CE_DESC(x,2,4);CE_DESC(x,6,8);CE_DESC(x,10,12);CE_DESC(x,1,9);
    CE_DESC(x,5,13);CE_DESC(x,5,9);CE_DESC(x,3,11);CE_DESC(x,7,15);CE_DESC(x,7,11);CE_DESC(x,3,5);CE_DESC(x,7,9);CE_DESC(x,11,13);CE_DESC(x,1,2);CE_DESC(x,3,4);CE_DESC(x,5,6);CE_DESC(x,7,8);CE_DESC(x,9,10);CE_DESC(x,11,12);CE_DESC(x,13,14);
}
__device__ __forceinline__ void merge_top16(float (&L)[16], const float (&S)[16]) {
#pragma unroll
    for (int j = 0; j < 16; ++j) L[j] = fmaxf(L[j], S[15 - j]);
    bitonic_merge16_desc(L);
}
#define INS16(L, v) do { float _v = (v); _Pragma("unroll") for (int _j = 0; _j < 16; ++_j) { const float _t = fmaxf(L[_j], _v); _v = fminf(L[_j], _v); L[_j] = _t; } } while (0)
__device__ __forceinline__ void topk_phase(const Args& A, LAS unsigned char* lds, int layer, int vcu, int G, int wave, int lane) {
    const bf16_t* Q2 = (const bf16_t*)(A.ws + WS_PROJ);
    const bf16_t* SK = (const bf16_t*)(A.ws + WS_SK) + (size_t)layer * 8 * 2 * 128 * 128;
    unsigned short* EXP = (unsigned short*)(A.ws + WS_EXP);
    bf16_t* GATE = (bf16_t*)(A.ws + WS_G16);
    LAS unsigned* lidx = (LAS unsigned*)(lds + 65536 + wave * 8192);
    const int r32 = lane & 31, hh = lane >> 5, tid = threadIdx.x;
    for (int grp = vcu; grp < T / 256; grp += G) {
      const int tb = grp * 8 + wave;
      bf16x8 QfN[8];
      { const bf16_t* qp = Q2 + ((((size_t)tb * 8 + 0) * 2 + 0) * 8 * 64 + lane) * 8;
#pragma unroll
        for (int s = 0; s < 8; ++s) QfN[s] = *(const bf16x8*)(qp + (size_t)s * 64 * 8); }
      u32x4 skn[8];
      { const u32x4* sp = (const u32x4*)SK + tid;
#pragma unroll
        for (int k = 0; k < 8; ++k) skn[k] = sp[k * 512]; }
#pragma unroll 1
      for (int h = 0; h < 8; ++h) {
        __syncthreads();
#pragma unroll
        for (int k = 0; k < 8; ++k) *(LAS u32x4*)(lds + (size_t)(tid + k * 512) * 16) = skn[k];
        if (h + 1 < 8) { const u32x4* sp = (const u32x4*)(SK + (size_t)(h + 1) * 2 * 128 * 128) + tid;
#pragma unroll
            for (int k = 0; k < 8; ++k) skn[k] = sp[k * 512]; }
        __syncthreads();
        const int t = tb * 32 + r32;
        bf16x8 Qh1[8];
        { const bf16_t* qp = Q2 + ((((size_t)tb * 8 + h) * 2 + 1) * 8 * 64 + lane) * 8;
#pragma unroll
          for (int s = 0; s < 8; ++s) Qh1[s] = *(const bf16x8*)(qp + (size_t)s * 64 * 8); }
        float La[16], Lb[16];
#pragma unroll
        for (int half = 0; half < 2; ++half) {
            bf16x8 Qf[8];
            if (half == 0) {
#pragma unroll
                for (int s = 0; s < 8; ++s) Qf[s] = QfN[s];
                if (h + 1 < 8) { const bf16_t* qn = Q2 + ((((size_t)tb * 8 + h + 1) * 2 + 0) * 8 * 64 + lane) * 8;
#pragma unroll
                    for (int s = 0; s < 8; ++s) QfN[s] = *(const bf16x8*)(qn + (size_t)s * 64 * 8); }
            } else {
#pragma unroll
              for (int s = 0; s < 8; ++s) Qf[s] = Qh1[s]; }
            float Ls[16];
#pragma unroll
            for (int j = 0; j < 16; ++j) Ls[j] = -3.0e38f;
            const LAS unsigned char* skb = lds + (size_t)half * 32768 + lane * 16;
#pragma unroll 1
            for (int kb = 0; kb < 4; ++kb) {
                f32x16 st;
#pragma unroll
                for (int i = 0; i < 16; ++i) st[i] = 0.f;
                const LAS unsigned char* kp = skb + kb * 8192;
#pragma unroll
                for (int s = 0; s < 8; ++s) { const bf16x8 Kf = *(const LAS bf16x8*)(kp + s * 1024); st = __builtin_amdgcn_mfma_f32_32x32x16_bf16(Kf, Qf[s], st, 0, 0, 0); }
                float Sb[16];
#pragma unroll
                for (int r = 0; r < 16; ++r) {
                    const unsigned idx = (unsigned)(kb * 32 + crow(r, hh));
                    Sb[r] = __uint_as_float((__float_as_uint(st[r]) & 0xffffff80u) | idx);
                }
                bitonic_sort16_desc(Sb);
                merge_top16(Ls, Sb);
            }
            float Po[16];
#pragma unroll
            for (int j = 0; j < 16; ++j) Po[j] = __shfl_xor(Ls[j], 32);
            merge_top16(Ls, Po);
#pragma unroll
            for (int j = 0; j < 16; ++j) { if (half == 0) La[j] = Ls[j]; else Lb[j] = Ls[j]; }
        }
#pragma unroll
        for (int j = 0; j < 16; ++j) { lidx[j * 64 + lane] = __float_as_uint(La[j]) & 0x7fu; lidx[(16 + j) * 64 + lane] = __float_as_uint(Lb[j]) & 0x7fu; }
#define CAND(i, j) __uint_as_float((__float_as_uint(La[i] + Lb[j]) & 0xffffff00u) | (unsigned)((i) * 16 + (j)))
        float Lc[16], M1[16], Y[16];
#pragma unroll
        for (int j = 0; j < 16; ++j) Lc[j] = CAND(0, j);
#pragma unroll
        for (int j = 0; j < 8; ++j) { M1[j] = CAND(1, j); M1[15 - j] = CAND(8 + j, 0); }
        bitonic_merge16_desc(M1);
        Y[0] = CAND(2, 0); Y[1] = CAND(2, 1); Y[2] = CAND(2, 2); Y[3] = CAND(2, 3); Y[4] = CAND(2, 4);
        Y[5] = CAND(3, 0); Y[6] = CAND(3, 1); Y[7] = CAND(3, 2); Y[8] = CAND(3, 3);
        Y[9] = CAND(4, 0); Y[10] = CAND(4, 1); Y[11] = CAND(4, 2);
        Y[12] = CAND(5, 0); Y[13] = CAND(5, 1); Y[14] = CAND(6, 0); Y[15] = CAND(6, 1);
        bitonic_sort16_desc(Y);
        merge_top16(Lc, M1);
        merge_top16(Lc, Y);
        { const float c70 = CAND(7, 0), c71 = CAND(7, 1); INS16(Lc, c70); INS16(Lc, c71); }
#undef CAND
        float e[16]; float es = 0.f;
#pragma unroll
        for (int j = 0; j < 16; ++j) { e[j] = __builtin_amdgcn_exp2f((Lc[j] - Lc[0]) * LOG2E); es += e[j]; }
        const float inv = __builtin_amdgcn_rcpf(es);
        asm volatile("s_waitcnt lgkmcnt(0)" ::: "memory");
        {
            unsigned ew[4], gw[4];
#pragma unroll
            for (int j2 = 0; j2 < 4; ++j2) {
                unsigned ev2[2]; float gv2[2];
#pragma unroll
                for (int u = 0; u < 2; ++u) {
                    const int j = 2 * j2 + u;
                    float la = Lc[j], lb = Lc[8 + j], ea = e[j], eb = e[8 + j];
                    asm volatile("" : "+v"(la), "+v"(lb), "+v"(ea), "+v"(eb));
                    const unsigned ci = __float_as_uint(hh ? lb : la) & 0xffu;
                    const unsigned i1 = lidx[(ci >> 4) * 64 + lane], i2 = lidx[(16 + (ci & 15)) * 64 + lane];
                    ev2[u] = i1 * 128 + i2; gv2[u] = (hh ? eb : ea) * inv;
                }
                ew[j2] = ev2[0] | (ev2[1] << 16); gw[j2] = cvt_pk_bf16(gv2[0], gv2[1]);
            }
            *(u32x4*)(EXP + (size_t)t * 128 + h * 16 + 8 * hh) = (u32x4){ew[0], ew[1], ew[2], ew[3]};
            *(u32x4*)(GATE + (size_t)t * 128 + h * 16 + 8 * hh) = (u32x4){gw[0], gw[1], gw[2], gw[3]};
        }
        asm volatile("s_waitcnt lgkmcnt(0)" ::: "memory");
      }
    }
}

#define XB_TMO      128
#define XB_XCNT(j)  (256  + 64 * (j))
#define XB_XSUB(j)  (1280 + 64 * (j))
#define XB_XGEN(j)  (2304 + 64 * (j))
#define XB_TOP      3328
#define XB_TOPGEN   3392
#define XCD_BAR_WORDS 3456
#define XB_SPIN_CAP (1u << 20)
__device__ __forceinline__ unsigned xb_ld(unsigned* p)              { return __hip_atomic_load(p, __ATOMIC_RELAXED, __HIP_MEMORY_SCOPE_AGENT); }
__device__ __forceinline__ unsigned xb_add(unsigned* p, unsigned v) { return __hip_atomic_fetch_add(p, v, __ATOMIC_RELAXED, __HIP_MEMORY_SCOPE_AGENT); }
__device__ __forceinline__ unsigned xb_xcc_id() { return (unsigned)__builtin_amdgcn_s_getreg((3 << 11) | 20) & 0xFu; }
#define XB_SPIN(cond, bar) do { unsigned _sp = 0; while (cond) { __builtin_amdgcn_s_sleep(1); \
    if ((++_sp & 255u) == 0u) { if (xb_ld(&(bar)[XB_TMO])) break; if (_sp > XB_SPIN_CAP) { atomicAdd(&(bar)[XB_TMO], 1u); break; } } } } while (0)
struct XcdBarrier { unsigned* bar; unsigned x; volatile LAS unsigned* st; };
__device__ __forceinline__ XcdBarrier xcd_barrier_post(unsigned* bar, volatile LAS unsigned* st) {
    XcdBarrier b; b.bar = bar; b.x = xb_xcc_id(); b.st = st;
    if (threadIdx.x == 0) (void)xb_add(&bar[XB_XCNT(b.x)], 1u);
    return b;
}
__device__ __forceinline__ void xcd_barrier_complete(unsigned* bar, unsigned x, unsigned& nloc, unsigned& nx) {
    const unsigned G = gridDim.x * gridDim.y * gridDim.z;
    unsigned sum, cnt, mine, sp = 0u;
    for (;;) {
        sum = 0u; cnt = 0u; mine = 0u;
#pragma unroll
        for (unsigned j = 0; j < 16; ++j) { const unsigned c = xb_ld(&bar[XB_XCNT(j)]); sum += c; cnt += (c > 0u) ? 1u : 0u; mine = (j == x) ? c : mine; }
        if (sum == G) break;
        __builtin_amdgcn_s_sleep(1);
        if ((++sp & 255u) == 0u) { if (xb_ld(&bar[XB_TMO])) break; if (sp > XB_SPIN_CAP) { atomicAdd(&bar[XB_TMO], 1u); break; } }
    }
    nloc = mine > 0u ? mine : 1u; nx = cnt > 0u ? cnt : 1u;
}
__device__ __forceinline__ void xcd_barrier(const XcdBarrier& b) {
    asm volatile("s_waitcnt vmcnt(0)" ::: "memory");
    __syncthreads();
    if (threadIdx.x == 0) {
        unsigned* bar = b.bar;
        __builtin_amdgcn_s_waitcnt(0);
        unsigned nloc = b.st[0], nx = b.st[1];
        if (nloc == 0u) { xcd_barrier_complete(bar, b.x, nloc, nx); b.st[0] = nloc; b.st[1] = nx; }
        const unsigned old = xb_add(&bar[XB_XSUB(b.x)], 1u);
        const unsigned gen = old / nloc;
        if (old + 1u == (gen + 1u) * nloc) {
            __builtin_amdgcn_fence(__ATOMIC_RELEASE, "agent");
            asm volatile("s_waitcnt vmcnt(0)" ::: "memory");
            const unsigned og = xb_add(&bar[XB_TOP], 1u);
            const unsigned tg = og / nx;
            if (og + 1u == (tg + 1u) * nx) xb_add(&bar[XB_TOPGEN], 1u);
            else XB_SPIN(xb_ld(&bar[XB_TOPGEN]) == tg, bar);
            __builtin_amdgcn_fence(__ATOMIC_ACQUIRE, "agent");
            xb_add(&bar[XB_XGEN(b.x)], 1u);
            asm volatile("s_waitcnt vmcnt(0)" ::: "memory");
        } else {
            XB_SPIN(xb_ld(&bar[XB_XGEN(b.x)]) == gen, bar);
            __builtin_amdgcn_fence(__ATOMIC_ACQUIRE, "agent");
            asm volatile("s_waitcnt vmcnt(0)" ::: "memory");
        }
    }
    __syncthreads();
}


__device__ __forceinline__ int dpp_sum_i32(int v) {
    v += __builtin_amdgcn_update_dpp(0, v, 0x111, 0xf, 0xf, true);
    v += __builtin_amdgcn_update_dpp(0, v, 0x112, 0xf, 0xf, true);
    v += __builtin_amdgcn_update_dpp(0, v, 0x114, 0xf, 0xf, true);
    v += __builtin_amdgcn_update_dpp(0, v, 0x118, 0xf, 0xf, true);
    v += __builtin_amdgcn_update_dpp(0, v, 0x142, 0xa, 0xf, false);
    v += __builtin_amdgcn_update_dpp(0, v, 0x143, 0xc, 0xf, false);
    return v;
}
typedef int v2i_t __attribute__((ext_vector_type(2)));
typedef int v8i_t __attribute__((ext_vector_type(8)));
constexpr int UP_STG = 4112;
constexpr int FU_LE = 132096, FU_LS = 136192, FU_LW = 140288, FU_LT = 148480, FU_LV = 150528, FU_HC = 152576, FU_OFF = 153088, FU_INV = 153600, FU_AMX = 153664;
__device__ __forceinline__ void expert_phase(const Args& A, LAS unsigned char* lds, int layer, int vcu, int G, int wave, int lane) {
    const unsigned char* WDQ = A.ws + WS_WDQ + (size_t)layer * NEXP * (DM / 2);
    const unsigned char* WUQ = A.ws + WS_WUQ + (size_t)layer * NEXP * (DM / 2);
    const f32x2* SDU = (const f32x2*)(A.ws + WS_SDU) + layer * NEXP;
    const float* SQ = (const float*)(A.ws + WS_SQ);
    const unsigned short* EXP = (const unsigned short*)(A.ws + WS_EXP);
    const unsigned short* GATE = (const unsigned short*)(A.ws + WS_G16);
    const bf16_t* X = (const bf16_t*)(A.ws + WS_XA);
    bf16_t* XO = (bf16_t*)(A.ws + WS_XA);
    bf16_t* XN = (bf16_t*)(A.ws + WS_OP);
    float* FO = A.out;
    const float* gfin = A.in[3];
    LAS unsigned short* LE = (LAS unsigned short*)(lds + FU_LE); LAS unsigned short* LS = (LAS unsigned short*)(lds + FU_LS); LAS float* LW = (LAS float*)(lds + FU_LW);
    LAS unsigned char* LT = lds + FU_LT; LAS unsigned char* LV = lds + FU_LV;
    LAS int* HC = (LAS int*)(lds + FU_HC); LAS int* OFF = (LAS int*)(lds + FU_OFF); LAS float* INV = (LAS float*)(lds + FU_INV); LAS unsigned* AMX = (LAS unsigned*)(lds + FU_AMX); LAS float* XSL = (LAS float*)(lds + FU_AMX + 64);
    const int tid = wave * 64 + lane, mi = lane & 15, kq = lane >> 4;
    const int tm = tid >> 5, ts = (tid & 31) * 4;
#define FU_FETCH(tbx) do { e2n = *(const u32x2*)(EXP + (size_t)((tbx) + tm) * 128 + ts); g2n = *(const u32x2*)(GATE + (size_t)((tbx) + tm) * 128 + ts); \
        _Pragma("unroll") for (int b2 = 0; b2 < 2; ++b2) { const bf16_t* xr = X + (size_t)((tbx) + 2 * wave + b2) * DM + 16 * lane; xpan[b2] = *(const u32x4*)xr; xpbn[b2] = *(const u32x4*)(xr + 8); } \
        sqpn = SQ[(size_t)((tbx) + 2 * wave + ((lane >> 4) & 1)) * 16 + (lane & 15)]; } while (0)
    u32x2 e2n, g2n; u32x4 xpan[2], xpbn[2]; float sqpn;
    const bool own = (G == T / 256);
    const int tb0 = own ? vcu * 256 : vcu * 16, tbs = own ? 16 : G * 16, tbe = own ? vcu * 256 + 256 : T;
    FU_FETCH(tb0);
    for (int tb = tb0; tb < tbe; tb += tbs) {
        const u32x2 e2 = e2n, g2 = g2n;
        const u32x4 xpa[2] = {xpan[0], xpan[1]}, xpb[2] = {xpbn[0], xpbn[1]};
        u32x4 xq8[2]; float xsc[2];
        { const float sqp = sqpn;
          float sq = sqp; sq += __shfl_xor(sq, 1); sq += __shfl_xor(sq, 2); sq += __shfl_xor(sq, 4); sq += __shfl_xor(sq, 8);
          const float ss0 = __builtin_bit_cast(float, __builtin_amdgcn_readlane(__builtin_bit_cast(int, sq), 0)), ss1 = __builtin_bit_cast(float, __builtin_amdgcn_readlane(__builtin_bit_cast(int, sq), 16));
#pragma unroll
          for (int b2 = 0; b2 < 2; ++b2) {
              const float rstd = __builtin_amdgcn_rsqf((b2 ? ss1 : ss0) * (1.0f / DM) + RMS_EPS);
              float hq[16];
#pragma unroll
              for (int k = 0; k < 4; ++k) { hq[2 * k] = bf_lo(xpa[b2][k]) * rstd; hq[2 * k + 1] = bf_hi(xpa[b2][k]) * rstd; hq[8 + 2 * k] = bf_lo(xpb[b2][k]) * rstd; hq[8 + 2 * k + 1] = bf_hi(xpb[b2][k]) * rstd; }
              float am = 0.f;
#pragma unroll
              for (int k = 0; k < 16; ++k) am = fmaxf(am, fabsf(hq[k]));
#pragma unroll
              for (int o = 1; o < 64; o <<= 1) am = fmaxf(am, __shfl_xor(am, o));
              const float amx = fmaxf(am, 1e-20f); const float inv = 240.0f / amx;
#pragma unroll
              for (int j = 0; j < 4; ++j) { int pk = __builtin_amdgcn_cvt_pk_fp8_f32(hq[4 * j] * inv, hq[4 * j + 1] * inv, 0, false);
                  pk = __builtin_amdgcn_cvt_pk_fp8_f32(hq[4 * j + 2] * inv, hq[4 * j + 3] * inv, pk, true); xq8[b2][j] = (unsigned)pk; }
              xsc[b2] = amx * (1.0f / 240.0f);
          } }
        int eq[4] = {(int)(e2.x & 0xffffu), (int)(e2.x >> 16), (int)(e2.y & 0xffffu), (int)(e2.y >> 16)};
        const unsigned gq[4] = {g2.x << 16, g2.x & 0xffff0000u, g2.y << 16, g2.y & 0xffff0000u};
        int rq[4], rank[4] = {0, 0, 0, 0}; int cntv = 0;
#pragma unroll
        for (int q = 0; q < 4; ++q) rq[q] = eq[q] >> 12;
#pragma unroll
        for (int r = 0; r < 4; ++r) {
            int before = 0;
#pragma unroll
            for (int q = 0; q < 4; ++q) {
                const unsigned long long bm = __builtin_amdgcn_ballot_w64(rq[q] == r);
                const int k0 = (int)__builtin_amdgcn_mbcnt_hi((unsigned)(bm >> 32), __builtin_amdgcn_mbcnt_lo((unsigned)bm, 0u));
                rank[q] = (rq[q] == r) ? before + k0 : rank[q];
                before += __builtin_popcountll(bm);
            }
            cntv = (lane == r) ? before : cntv;
        }
        __syncthreads();
        if (lane < 16) HC[lane * 8 + wave] = cntv;
        if (tid < 16) AMX[tid] = 0u;
#pragma unroll
        for (int b2 = 0; b2 < 2; ++b2) { const int xm = 2 * wave + b2; *(LAS u32x4*)(lds + xm * 1024 + ((lane ^ xm) << 4)) = xq8[b2]; if (lane == 0) XSL[xm] = xsc[b2]; }
        __syncthreads();
        const f32x4 xs4 = *(const LAS f32x4*)(XSL + 4 * kq);
        v8i_t xa[8];
#pragma unroll
        for (int s = 0; s < 8; ++s) { const u32x4 lo = *(const LAS u32x4*)(lds + mi * 1024 + (((8 * s + kq) ^ mi) << 4)), hi = *(const LAS u32x4*)(lds + mi * 1024 + (((8 * s + 4 + kq) ^ mi) << 4));
            xa[s] = (v8i_t){(int)lo.x, (int)lo.y, (int)lo.z, (int)lo.w, (int)hi.x, (int)hi.y, (int)hi.z, (int)hi.w}; }
        if (wave == 0) { const int a0 = HC[2 * lane], a1 = HC[2 * lane + 1]; const int s2 = a0 + a1; const int incl = dpp_sum_i32(s2); OFF[2 * lane] = incl - s2; OFF[2 * lane + 1] = incl - s2 + a0; }
        __syncthreads();
#pragma unroll
        for (int q = 0; q < 4; ++q) { const int p = OFF[rq[q] * 8 + wave] + rank[q]; LE[p] = (unsigned short)eq[q]; LS[p] = (unsigned short)((tm << 7) | (ts + q)); LW[p] = __uint_as_float(gq[q]); LT[p] = (unsigned char)tm; }
        __syncthreads();
#define DN_DMA(i) do { const int bo_ = wave * 16384 + ((i) & 1) * 8192; int ev_[8]; \
            _Pragma("unroll") for (int j = 0; j < 8; ++j) ev_[j] = LE[(i) * 128 + wave * 16 + 2 * j + (lane >> 5)]; \
            _Pragma("unroll") for (int j = 0; j < 8; ++j) { const int g_ = (lane & 31) ^ (2 * j + (lane >> 5)); \
                __builtin_amdgcn_global_load_lds((const unsigned*)(WDQ + (size_t)ev_[j] * (DM / 2) + g_ * 16), (LAS unsigned*)(lds + bo_ + j * 1024), 16, 0, 0); } } while (0)
        DN_DMA(0);
        f32x2 sdn = SDU[LE[wave * 16 + mi]];
#pragma unroll 1
        for (int i = 0; i < 16; ++i) {
            asm volatile("s_waitcnt vmcnt(0)" ::: "memory");
            const f32x2 sdc = sdn;
            if (i + 1 < 16) { DN_DMA(i + 1); sdn = SDU[LE[(i + 1) * 128 + wave * 16 + mi]]; }
            u32x4 bw[8];
            {
              const int plo = wave * 16384 + (i & 1) * 8192 + mi * 512 + ((kq ^ (mi & 3)) << 4);
              const int p0 = plo + ((0 ^ (mi >> 2)) << 6), p1 = plo + ((1 ^ (mi >> 2)) << 6), p2 = plo + ((2 ^ (mi >> 2)) << 6), p3 = plo + ((3 ^ (mi >> 2)) << 6);
              asm volatile("ds_read_b128 %0, %8\n\tds_read_b128 %1, %9\n\tds_read_b128 %2, %10\n\tds_read_b128 %3, %11\n\t"
                           "ds_read_b128 %4, %8 offset:256\n\tds_read_b128 %5, %9 offset:256\n\tds_read_b128 %6, %10 offset:256\n\tds_read_b128 %7, %11 offset:256\n\t"
                           "s_waitcnt lgkmcnt(0)"
                           : "=&v"(bw[0]), "=&v"(bw[1]), "=&v"(bw[2]), "=&v"(bw[3]), "=&v"(bw[4]), "=&v"(bw[5]), "=&v"(bw[6]), "=&v"(bw[7])
                           : "v"(p0), "v"(p1), "v"(p2), "v"(p3) : "memory"); }
            f32x4 dacc = {0.f, 0.f, 0.f, 0.f};
#pragma unroll
            for (int s = 0; s < 8; ++s) {
                const v8i_t Bv = {(int)bw[s].x, (int)bw[s].y, (int)bw[s].z, (int)bw[s].w, 0, 0, 0, 0};
                dacc = __builtin_amdgcn_mfma_scale_f32_16x16x128_f8f6f4(xa[s], Bv, dacc, 0, 4, 0, 0x7f7f7f7f, 0, 0x7f7f7f7f);
            }
            asm volatile("" : "+v"(dacc));
            const int slot = i * 128 + wave * 16 + mi;
            const unsigned ls = LS[slot]; const float gt = LW[slot];
            const int own = (int)(ls >> 7) - 4 * kq;
            if (own >= 0 && own < 4) {
                const float hv = own == 0 ? dacc[0] * xs4[0] : own == 1 ? dacc[1] * xs4[1] : own == 2 ? dacc[2] * xs4[2] : dacc[3] * xs4[3];
                const float cf = gt * gelu_tanh(hv * sdc[0]) * sdc[1];
                LW[slot] = cf;
                __hip_atomic_fetch_max(AMX + (ls >> 7), __float_as_uint(fabsf(cf)), __ATOMIC_RELAXED, __HIP_MEMORY_SCOPE_WORKGROUP);
            }
        }
#undef DN_DMA
        __syncthreads();
        { const f32x4 c4 = *(const LAS f32x4*)(LW + 4 * tid); const unsigned t4 = *(const LAS unsigned*)(LT + 4 * tid);
          float sc4[4];
#pragma unroll
          for (int q = 0; q < 4; ++q) { const float am = __uint_as_float(AMX[(t4 >> (8 * q)) & 15u]); sc4[q] = am > 1e-30f ? 240.0f / am : 0.f; }
          int v8 = __builtin_amdgcn_cvt_pk_fp8_f32(c4[0] * sc4[0], c4[1] * sc4[1], 0, false);
          v8 = __builtin_amdgcn_cvt_pk_fp8_f32(c4[2] * sc4[2], c4[3] * sc4[3], v8, true);
          *(LAS int*)(LV + 4 * tid) = v8;
          if (tid < 16) INV[tid] = __uint_as_float(AMX[tid]) * (1.0f / 240.0f); }
        __syncthreads();
#define UP_DMA(b) do { const int bo_ = ((b) & 1) * 65536 + wave * 8192; int ev_[8]; \
            _Pragma("unroll") for (int j = 0; j < 8; ++j) ev_[j] = LE[(b) * 128 + wave * 16 + 2 * j + (lane >> 5)]; \
            _Pragma("unroll") for (int j = 0; j < 8; ++j) { const int g_ = (lane & 31) ^ (2 * j + (lane >> 5)); \
                __builtin_amdgcn_global_load_lds((const unsigned*)(WUQ + (size_t)ev_[j] * (DM / 2) + g_ * 16), (LAS unsigned*)(lds + bo_ + j * 1024), 16, 0, 0); } } while (0)
        f32x4 acc[8];
#pragma unroll
        for (int nt = 0; nt < 8; ++nt) acc[nt] = (f32x4){0.f, 0.f, 0.f, 0.f};
        const int mm = mi * 0x01010101;
        int aq[4];
#pragma unroll
        for (int q = 0; q < 4; ++q) aq[q] = (kq * 32 + mi) * 512 + ((((wave * 4) ^ mi) ^ q) << 4);
        { const int tbn = (tb + tbs < tbe) ? tb + tbs : tb; FU_FETCH(tbn); }
        UP_DMA(0);
#pragma unroll 1
        for (int b = 0; b < 16; ++b) {
            asm volatile("s_waitcnt vmcnt(0)" ::: "memory");
            __builtin_amdgcn_s_barrier();
            if (b + 1 < 16) UP_DMA(b + 1);
            const u32x4 t0 = *(const LAS u32x4*)(LT + b * 128 + kq * 16), t1 = *(const LAS u32x4*)(LT + b * 128 + 64 + kq * 16);
            const u32x4 w0 = *(const LAS u32x4*)(LV + b * 128 + kq * 16), w1 = *(const LAS u32x4*)(LV + b * 128 + 64 + kq * 16);
            v8i_t Av;
#pragma unroll
            for (int d = 0; d < 8; ++d) {
                const unsigned tx = (d < 4 ? t0[d & 3] : t1[d & 3]) ^ (unsigned)mm, wv = d < 4 ? w0[d & 3] : w1[d & 3];
                const unsigned y = (tx | 0x80808080u) - 0x01010101u;
                const unsigned m80 = ~y & 0x80808080u;
                Av[d] = (int)(wv & (m80 | (m80 - (m80 >> 7))));
            }
            const int bb = (b & 1) * 65536;
            v2i_t rr[16];
            { const int p0 = bb + aq[0], p1 = bb + aq[1], p2 = bb + aq[2], p3 = bb + aq[3];
              asm volatile("ds_read_b64_tr_b4 %0, %16\n\tds_read_b64_tr_b4 %1, %16 offset:8192\n\tds_read_b64_tr_b4 %2, %16 offset:8\n\tds_read_b64_tr_b4 %3, %16 offset:8200\n\t"
                           "ds_read_b64_tr_b4 %4, %17\n\tds_read_b64_tr_b4 %5, %17 offset:8192\n\tds_read_b64_tr_b4 %6, %17 offset:8\n\tds_read_b64_tr_b4 %7, %17 offset:8200\n\t"
                           "ds_read_b64_tr_b4 %8, %18\n\tds_read_b64_tr_b4 %9, %18 offset:8192\n\tds_read_b64_tr_b4 %10, %18 offset:8\n\tds_read_b64_tr_b4 %11, %18 offset:8200\n\t"
                           "ds_read_b64_tr_b4 %12, %19\n\tds_read_b64_tr_b4 %13, %19 offset:8192\n\tds_read_b64_tr_b4 %14, %19 offset:8\n\tds_read_b64_tr_b4 %15, %19 offset:8200\n\t"
                           "s_waitcnt lgkmcnt(0)"
                           : "=&v"(rr[0]), "=&v"(rr[1]), "=&v"(rr[2]), "=&v"(rr[3]), "=&v"(rr[4]), "=&v"(rr[5]), "=&v"(rr[6]), "=&v"(rr[7]),
                             "=&v"(rr[8]), "=&v"(rr[9]), "=&v"(rr[10]), "=&v"(rr[11]), "=&v"(rr[12]), "=&v"(rr[13]), "=&v"(rr[14]), "=&v"(rr[15])
                           : "v"(p0), "v"(p1), "v"(p2), "v"(p3) : "memory"); }
#pragma unroll
            for (int nt = 0; nt < 8; ++nt) {
                const v2i_t r1 = rr[2 * nt], r2 = rr[2 * nt + 1];
                const v8i_t Bv = {r1.x, r1.y, r2.x, r2.y, 0, 0, 0, 0};
                acc[nt] = __builtin_amdgcn_mfma_scale_f32_16x16x128_f8f6f4(Av, Bv, acc[nt], 0, 4, 0, 0x7f7f7f7f, 0, 0x7f7f7f7f);
            }
        }
#undef UP_DMA
        __syncthreads();
        {
            const f32x4 inv4 = *(const LAS f32x4*)(INV + 4 * kq);
#pragma unroll
            for (int nt = 0; nt < 8; ++nt)
#pragma unroll
                for (int r = 0; r < 4; ++r) *(LAS float*)(lds + (4 * kq + r) * UP_STG + (wave * 128 + nt * 16 + mi) * 4) = acc[nt][r] * inv4[r];
        }
        __syncthreads();
#pragma unroll
        for (int b2 = 0; b2 < 2; ++b2) {
            const int t = tb + 2 * wave + b2;
            f32x4 x[4];
            { const u32x4 xa = xpa[b2], xb2 = xpb[b2];
              x[0] = (f32x4){bf_lo(xa.x), bf_hi(xa.x), bf_lo(xa.y), bf_hi(xa.y)}; x[1] = (f32x4){bf_lo(xa.z), bf_hi(xa.z), bf_lo(xa.w), bf_hi(xa.w)};
              x[2] = (f32x4){bf_lo(xb2.x), bf_hi(xb2.x), bf_lo(xb2.y), bf_hi(xb2.y)}; x[3] = (f32x4){bf_lo(xb2.z), bf_hi(xb2.z), bf_lo(xb2.w), bf_hi(xb2.w)}; }
            float ss = 0.f;
#pragma unroll
            for (int j = 0; j < 4; ++j) { x[j] = x[j] + *(const LAS f32x4*)(lds + (2 * wave + b2) * UP_STG + lane * 64 + j * 16);
                ss += (x[j][0] * x[j][0] + x[j][1] * x[j][1]) + (x[j][2] * x[j][2] + x[j][3] * x[j][3]); }
            const float r2 = __builtin_amdgcn_rsqf(wave_sum(ss) * (1.0f / DM) + RMS_EPS);
            if (layer == 0) {
                bf16_t* ox = XO + (size_t)t * DM + 16 * lane; bf16_t* on = XN + (size_t)t * DM + 16 * lane;
                u32x4 w; w.x = cvt_pk_bf16(x[0][0], x[0][1]); w.y = cvt_pk_bf16(x[0][2], x[0][3]); w.z = cvt_pk_bf16(x[1][0], x[1][1]); w.w = cvt_pk_bf16(x[1][2], x[1][3]);
                *(u32x4*)ox = w;
                w.x = cvt_pk_bf16(x[2][0], x[2][1]); w.y = cvt_pk_bf16(x[2][2], x[2][3]); w.z = cvt_pk_bf16(x[3][0], x[3][1]); w.w = cvt_pk_bf16(x[3][2], x[3][3]);
                *(u32x4*)(ox + 8) = w;
                w.x = cvt_pk_bf16(x[0][0] * r2, x[0][1] * r2); w.y = cvt_pk_bf16(x[0][2] * r2, x[0][3] * r2); w.z = cvt_pk_bf16(x[1][0] * r2, x[1][1] * r2); w.w = cvt_pk_bf16(x[1][2] * r2, x[1][3] * r2);
                *(u32x4*)on = w;
                w.x = cvt_pk_bf16(x[2][0] * r2, x[2][1] * r2); w.y = cvt_pk_bf16(x[2][2] * r2, x[2][3] * r2); w.z = cvt_pk_bf16(x[3][0] * r2, x[3][1] * r2); w.w = cvt_pk_bf16(x[3][2] * r2, x[3][3] * r2);
                *(u32x4*)(on + 8) = w;
            } else {
                float* xo = FO + (size_t)t * DM + 16 * lane;
#pragma unroll
                for (int j = 0; j < 4; ++j) { const f32x4 g = *(const f32x4*)(gfin + 16 * lane + 4 * j); *(f32x4*)(xo + 4 * j) = x[j] * r2 * g; }
            }
        }
    }
}


#undef FU_FETCH
__device__ __forceinline__ void sgu_phase(const Args& A, LAS unsigned char* lds, int vcu, int G, int wave, int lane) {
    const bf16_t* U = (const bf16_t*)(A.ws + WS_PROJ);
    const bf16_t* V = (const bf16_t*)(A.ws + WS_PROJ) + (size_t)T * DM;
    const float* SQ2 = (const float*)(A.ws + WS_SQ2);
    const bf16_t* WS_ = (const bf16_t*)(A.ws + WS_WS);
    bf16_t* Gt = (bf16_t*)(A.ws + WS_MIX);
    const float* c_norm = A.in[9]; const float* b_s = A.in[11];
    const int fr = lane & 15, fq = lane >> 4, tid = threadIdx.x;
    constexpr int WROW = 272, WBUF = 128 * WROW;
    LAS unsigned char* ldsV = lds + 2 * WBUF;
    LAS float* lrs = (LAS float*)(lds + 4 * WBUF);
    const int srow = tid >> 2, sseg = tid & 3;
    for (int ch = vcu; ch < T / 128; ch += G) {
        lds_barrier();
        float myr;
        { const f32x4* sp = (const f32x4*)(SQ2 + (size_t)(ch * 128 + srow) * 16);
          const f32x4 a = sp[0], b = sp[1], c = sp[2], d = sp[3];
          const float sm = ((a[0] + a[1]) + (a[2] + a[3])) + ((b[0] + b[1]) + (b[2] + b[3])) + ((c[0] + c[1]) + (c[2] + c[3])) + ((d[0] + d[1]) + (d[2] + d[3]));
          myr = __builtin_amdgcn_rsqf(sm * (1.0f / DM) + RMS_EPS); }
        u32x4 wn[4], vn[4], vn2[4];
        { const u32x4* wp = (const u32x4*)(WS_ + (size_t)srow * 128 + sseg * 32);
          const u32x4* vp = (const u32x4*)(V + (size_t)(ch * 128 + srow) * DM + sseg * 32);
#pragma unroll
          for (int k = 0; k < 4; ++k) { wn[k] = wp[k]; vn[k] = vp[k]; vn2[k] = vp[k + 16]; } }
        u32x2 uuN[8];
#pragma unroll
        for (int pb = 0; pb < 8; ++pb) uuN[pb] = *(const u32x2*)(U + (size_t)(ch * 128 + pb * 16 + fr) * DM + 16 * wave + 4 * fq);
#pragma unroll 1
        for (int g = 0; g < 8; ++g) {
            LAS unsigned char* wcur = lds + (g & 1) * WBUF; LAS unsigned char* vcur = ldsV + (g & 1) * WBUF;
            const f32x4 cn = *(const f32x4*)(c_norm + g * 128 + 16 * wave + 4 * fq);
            float bsv[8];
#pragma unroll
            for (int pb = 0; pb < 8; ++pb) bsv[pb] = b_s[g * 128 + pb * 16 + fr];
            { LAS u32x4* lp = (LAS u32x4*)(wcur + srow * WROW + sseg * 64); LAS u32x4* lv = (LAS u32x4*)(vcur + srow * WROW + sseg * 64);
#pragma unroll
              for (int k = 0; k < 4; ++k) {
                  lp[k] = wn[k];
                  u32x4 w;
#pragma unroll
                  for (int e = 0; e < 4; ++e) w[e] = cvt_pk_bf16(bf_lo(vn[k][e]) * myr, bf_hi(vn[k][e]) * myr);
                  lv[k] = w; } }
            if (g + 1 < 8) { const u32x4* wp = (const u32x4*)(WS_ + (size_t)(g + 1) * 128 * 128 + (size_t)srow * 128 + sseg * 32);
#pragma unroll
                for (int k = 0; k < 4; ++k) { wn[k] = wp[k]; vn[k] = vn2[k]; } }
            if (g + 2 < 8) { const u32x4* vp = (const u32x4*)(V + (size_t)(ch * 128 + srow) * DM + (g + 2) * 128 + sseg * 32);
#pragma unroll
                for (int k = 0; k < 4; ++k) vn2[k] = vp[k]; }
            const int c0 = g * 128 + 16 * wave + 4 * fq;
            u32x2 uu[8];
#pragma unroll
            for (int pb = 0; pb < 8; ++pb) uu[pb] = uuN[pb];
            if (g + 1 < 8) {
#pragma unroll
                for (int pb = 0; pb < 8; ++pb) uuN[pb] = *(const u32x2*)(U + (size_t)(ch * 128 + pb * 16 + fr) * DM + c0 + 128);
            }
            lds_barrier();
            f32x4 acc[8];
#pragma unroll
            for (int pb = 0; pb < 8; ++pb) acc[pb] = (f32x4){0.f, 0.f, 0.f, 0.f};
#pragma unroll
            for (int s = 0; s < 4; ++s) {
                LAS unsigned char* a0 = vcur + (32 * s + 8 * fq + (fr >> 2)) * WROW + (16 * wave + 4 * (fr & 3)) * 2;
                const s16x4 t0 = __builtin_bit_cast(s16x4, __builtin_amdgcn_ds_read_tr16_b64_v4i16((LAS s16x4*)a0));
                const s16x4 t1 = __builtin_bit_cast(s16x4, __builtin_amdgcn_ds_read_tr16_b64_v4i16((LAS s16x4*)(a0 + 4 * WROW)));
                const bf16x8 Vf = (bf16x8){t0[0], t0[1], t0[2], t0[3], t1[0], t1[1], t1[2], t1[3]};
#pragma unroll
                for (int pb = 0; pb < 8; ++pb) {
                    const bf16x8 Wf = *(const LAS bf16x8*)(wcur + (pb * 16 + fr) * WROW + 64 * s + 16 * fq);
                    acc[pb] = __builtin_amdgcn_mfma_f32_16x16x32_bf16(Vf, Wf, acc[pb], 0, 0, 0);
                }
                asm volatile("" ::: "memory");
            }
#pragma unroll
            for (int pb = 0; pb < 8; ++pb) {
                const int p = pb * 16 + fr;
                const float bs = bsv[pb];
                const f32x4 mx = acc[pb] * cn + bs;
                u32x2 w; w.x = cvt_pk_bf16(bf_lo(uu[pb].x) * mx[0], bf_hi(uu[pb].x) * mx[1]); w.y = cvt_pk_bf16(bf_lo(uu[pb].y) * mx[2], bf_hi(uu[pb].y) * mx[3]);
                *(u32x2*)(Gt + (size_t)(ch * 128 + p) * DM + c0) = w;
            }
        }
    }
}

constexpr int NPHASE = 14;
__global__ void __launch_bounds__(NWAVES * 64, 2) mk_fwd(Args args) {
    extern __shared__ __attribute__((aligned(16))) unsigned char lds_raw[];
    LAS unsigned char* lds = (LAS unsigned char*)lds_raw;
    const int tid = threadIdx.x, lane = tid & 63, wave = __builtin_amdgcn_readfirstlane(tid >> 6);
    const int G = gridDim.x; const int bx = blockIdx.x;
    const int vcu = (G % 8 == 0) ? (bx % 8) * (G / 8) + bx / 8 : bx;
    unsigned char* ws = args.ws;
    const int lo = args.ph_lo, hi = args.ph_hi;
#ifndef REP_MASK
#define REP_MASK 0u
#endif
#define REP(k) (((REP_MASK >> (k)) & 1u) != 0u)
#ifndef PH_MASK
#define PH_MASK 0xffffffffu
#endif
#define IN(k) (((PH_MASK >> (k)) & 1u) && lo <= (k) && (k) < hi)
    cg::grid_group grid = cg::this_grid();
    {
        volatile LAS unsigned* stw = (volatile LAS unsigned*)(lds + LDS_BARST);
        if (tid < 2) stw[tid] = 0u;
        __syncthreads();
    }
    const XcdBarrier xbar = xcd_barrier_post((unsigned*)(ws + WS_CTL) + 1024, (volatile LAS unsigned*)(lds + LDS_BARST));
    if (lo < 0) grid.sync();
#define SEAM(k) do { if (IN(k) && IN((k) + 1)) xcd_barrier(xbar); } while (0)
#define RSYNC() xcd_barrier(xbar)
    bf16_t* XA = (bf16_t*)(ws + WS_XA); bf16_t* PROJ = (bf16_t*)(ws + WS_PROJ); bf16_t* MIX = (bf16_t*)(ws + WS_MIX);
    float* SQ = (float*)(ws + WS_SQ); float* SQ2 = (float*)(ws + WS_SQ2);

    if (IN(0)) { if (REP(0)) { p0_prologue(args, lds, vcu, G, wave, lane); RSYNC(); } p0_prologue(args, lds, vcu, G, wave, lane); }
    SEAM(0);
    if (IN(1)) { if (REP(1)) { { pg8::Gemm g{XA, (const bf16_t*)(ws + WS_WABIN), T, 2048, DM}; pg8::StaticOrder S; S.init(T, 2048, G, bx);
        pg8::EpiProj E{PROJ, (const float*)(ws + WS_TAB)}; pg8::gemm_phase(lds, g, S, E); } RSYNC(); } { pg8::Gemm g{XA, (const bf16_t*)(ws + WS_WABIN), T, 2048, DM}; pg8::StaticOrder S; S.init(T, 2048, G, bx);
        pg8::EpiProj E{PROJ, (const float*)(ws + WS_TAB)}; pg8::gemm_phase(lds, g, S, E); } }
    SEAM(1);
    if (IN(2)) { if (REP(2)) { attn_phase(args, lds, vcu, G, wave, lane); RSYNC(); } attn_phase(args, lds, vcu, G, wave, lane); }
    SEAM(2);
    if (IN(3)) { if (REP(3)) { mixab_phase(args, lds, vcu, G, wave, lane); RSYNC(); } mixab_phase(args, lds, vcu, G, wave, lane); }
    SEAM(3);
    if (IN(4)) { if (REP(4)) { { pg8::Gemm g{MIX, (const bf16_t*)(ws + WS_WABOUT), T, 1024, DM}; pg8::StaticOrder S; S.init(T, 1024, G, bx);
        pg8::EpiRes E{args.in[0], nullptr, XA, SQ}; pg8::gemm_phase(lds, g, S, E); } RSYNC(); } { pg8::Gemm g{MIX, (const bf16_t*)(ws + WS_WABOUT), T, 1024, DM}; pg8::StaticOrder S; S.init(T, 1024, G, bx);
        pg8::EpiRes E{args.in[0], nullptr, XA, SQ}; pg8::gemm_phase(lds, g, S, E); } }
    SEAM(4);
    if (IN(5) && REP(19)) { pg8::Gemm g{XA, (const bf16_t*)(ws + WS_WQ0), T, 2048, DM}; pg8::StaticOrder S; S.init(T, 2048, G, bx);
        pg8::EpiScaled E{PROJ, NPROJ, SQ, true, true}; pg8::gemm_phase(lds, g, S, E); RSYNC(); }
    if (IN(5)) { if (REP(5)) { { pg8::Gemm g{XA, (const bf16_t*)(ws + WS_WQ0), T, 2048, DM}; pg8::StaticOrder S; S.init(T, 2048, G, bx);
        pg8::EpiScaled E{PROJ, NPROJ, SQ, false, true}; pg8::gemm_phase(lds, g, S, E); } RSYNC(); } { pg8::Gemm g{XA, (const bf16_t*)(ws + WS_WQ0), T, 2048, DM}; pg8::StaticOrder S; S.init(T, 2048, G, bx);
        pg8::EpiScaled E{PROJ, NPROJ, SQ, false, true}; pg8::gemm_phase(lds, g, S, E); } }
    SEAM(5);
    if (IN(6)) { if (REP(6)) { topk_phase(args, lds, 0, vcu, G, wave, lane); RSYNC(); } topk_phase(args, lds, 0, vcu, G, wave, lane); }
    if (IN(6) && IN(7)) { if (G == T / 256) __syncthreads(); else xcd_barrier(xbar); }
    if (IN(7)) { expert_phase(args, lds, 0, vcu, G, wave, lane); }
    SEAM(7);
    if (IN(8)) { if (REP(8)) { { pg8::Gemm g{(const bf16_t*)(ws + WS_OP), (const bf16_t*)(ws + WS_WCIN), T, 2048, DM}; pg8::StaticOrder S; S.init(T, 2048, G, bx);
        pg8::EpiGelu E{PROJ, PROJ + (size_t)T * DM, SQ2}; pg8::gemm_phase(lds, g, S, E); } RSYNC(); } { pg8::Gemm g{(const bf16_t*)(ws + WS_OP), (const bf16_t*)(ws + WS_WCIN), T, 2048, DM}; pg8::StaticOrder S; S.init(T, 2048, G, bx);
        pg8::EpiGelu E{PROJ, PROJ + (size_t)T * DM, SQ2}; pg8::gemm_phase(lds, g, S, E); } }
    SEAM(8);
    if (IN(9)) { if (REP(9)) { sgu_phase(args, lds, vcu, G, wave, lane); RSYNC(); } sgu_phase(args, lds, vcu, G, wave, lane); }
    SEAM(9);
    if (IN(10)) { if (REP(10)) { { pg8::Gemm g{MIX, (const bf16_t*)(ws + WS_WCOUT), T, 1024, DM}; pg8::StaticOrder S; S.init(T, 1024, G, bx);
        pg8::EpiRes E{nullptr, XA, XA, SQ}; pg8::gemm_phase(lds, g, S, E); } RSYNC(); } { pg8::Gemm g{MIX, (const bf16_t*)(ws + WS_WCOUT), T, 1024, DM}; pg8::StaticOrder S; S.init(T, 1024, G, bx);
        pg8::EpiRes E{nullptr, XA, XA, SQ}; pg8::gemm_phase(lds, g, S, E); } }
    SEAM(10);
    if (IN(11)) { if (REP(11)) { { pg8::Gemm g{XA, (const bf16_t*)(ws + WS_WQ1), T, 2048, DM}; pg8::StaticOrder S; S.init(T, 2048, G, bx);
        pg8::EpiScaled E{PROJ, NPROJ, SQ, false, true}; pg8::gemm_phase(lds, g, S, E); } RSYNC(); } { pg8::Gemm g{XA, (const bf16_t*)(ws + WS_WQ1), T, 2048, DM}; pg8::StaticOrder S; S.init(T, 2048, G, bx);
        pg8::EpiScaled E{PROJ, NPROJ, SQ, false, true}; pg8::gemm_phase(lds, g, S, E); } }
    SEAM(11);
    if (IN(12)) { if (REP(12)) { topk_phase(args, lds, 1, vcu, G, wave, lane); RSYNC(); } topk_phase(args, lds, 1, vcu, G, wave, lane); }
    if (IN(12) && IN(13)) { if (G == T / 256) __syncthreads(); else xcd_barrier(xbar); }
    if (IN(13)) { expert_phase(args, lds, 1, vcu, G, wave, lane); }
#undef IN
#undef SEAM
}

extern "C" void kernel_launch(void* const* d_in, const int* in_sizes, int n_in, void* d_out, int out_size, void* d_ws, size_t ws_size, hipStream_t stream) {
    static int grid = 0;
    if (grid == 0) {
        if (n_in != 17 || in_sizes[0] != T * DM || out_size != T * DM || ws_size < WS_END) {
            fprintf(stderr, "kernel_launch: unexpected shapes: n_in %d in0 %d out %d ws %zu (need %zu)\n", n_in, n_in > 0 ? in_sizes[0] : -1, out_size, ws_size, (size_t)WS_END); grid = -1; return; }
        int dev = 0, cus = 0, per_cu = 0;
        hipGetDevice(&dev);
        hipDeviceGetAttribute(&cus, hipDeviceAttributeMultiprocessorCount, dev);
        hipFuncSetAttribute((const void*)mk_fwd, hipFuncAttributeMaxDynamicSharedMemorySize, LDS_BYTES);
        hipOccupancyMaxActiveBlocksPerMultiprocessor(&per_cu, (const void*)mk_fwd, NWAVES * 64, LDS_BYTES);
        if (per_cu < 1) { fprintf(stderr, "kernel_launch: occupancy query says %d blocks per CU\n", per_cu); per_cu = 1; }
        (void)hipGetLastError();
        grid = cus;
    }
    if (grid < 0) return;
    if (hipMemsetAsync((char*)d_ws + WS_CTL, 0, 64 * 1024, stream) != hipSuccess) { fprintf(stderr, "kernel_launch: memset of control words failed\n"); return; }
    Args a{};
    for (int i = 0; i < 17; ++i) a.in[i] = (const float*)d_in[i];
    a.out = (float*)d_out; a.ws = (unsigned char*)d_ws;
    a.ph_lo = 0; a.ph_hi = NPHASE;
    void* kargs[] = {&a};
    hipError_t e = hipLaunchCooperativeKernel((const void*)mk_fwd, dim3(grid), dim3(NWAVES * 64), kargs, LDS_BYTES, stream);
    if (e != hipSuccess) fprintf(stderr, "cooperative launch failed: %s (grid %d)\n", hipGetErrorString(e), grid);
}
```
